# Optimizing an MI355X kernel written in HIP

```python
import math
import jax, jax.numpy as jnp
from jax import lax
import numpy as np

D_MODEL = 2048
BATCH = 8
SEQ = 2048
DEPTH = 1

MIX_WIDTH = D_MODEL
POOL_WIDTH = D_MODEL // 2
POOL_WINDOWS = (2, 4, 8, 16)
POOL_GROUP = POOL_WIDTH // len(POOL_WINDOWS)
RET_WIDTH = MIX_WIDTH - POOL_WIDTH
RET_HEADS = 4
RET_HEAD_DIM = RET_WIDTH // RET_HEADS
RET_CHUNK = 128
ROPE_BASE = 10000.0
D_FF = -(-8 * D_MODEL // (3 * 256)) * 256
IN_WIDTH = POOL_WIDTH + 4 * RET_WIDTH
N_MOD = 6
EPS = 1e-6

kernel_name = 'hybrid_pool_retention_encoder_block'


def rmsnorm(x, g):
    xf = x.astype(jnp.float32)
    y = xf * lax.rsqrt(jnp.mean(xf * xf, axis=-1, keepdims=True) + EPS)
    return (y * g.astype(jnp.float32)).astype(x.dtype)


def rotary(t):
    S, dh = t.shape[2], t.shape[3]
    half = dh // 2
    inv = 1.0 / (ROPE_BASE ** jnp.linspace(0.0, 1.0, half, dtype=jnp.float32))
    ang = jnp.arange(S, dtype=jnp.float32)[:, None] * inv[None, :]
    cos, sin = jnp.cos(ang), jnp.sin(ang)
    t1, t2 = t[..., :half], t[..., half:]
    return jnp.concatenate([t1 * cos - t2 * sin, t1 * sin + t2 * cos], axis=-1)


def multi_scale_pool(u):
    S = u.shape[1]
    t = jnp.arange(S)
    outs = []
    for gi, w in enumerate(POOL_WINDOWS):
        ug = u[..., gi * POOL_GROUP:(gi + 1) * POOL_GROUP].astype(jnp.float32)
        cs = jnp.concatenate([jnp.zeros_like(ug[:, :1]), jnp.cumsum(ug, axis=1)], axis=1)
        lo = jnp.clip(t - w // 2, 0, S)
        hi = jnp.clip(t + w // 2, 0, S)
        total = cs[:, hi] - cs[:, lo]
        count = (hi - lo).astype(jnp.float32)[None, :, None]
        outs.append(total / count - ug)
    return jnp.concatenate(outs, axis=-1)


def retention_one_direction(q, k, v, log_gamma, include_diag):
    B, H, S, dh = q.shape
    C = RET_CHUNK
    n = S // C
    qc = q.reshape(B, H, n, C, dh)
    kc = k.reshape(B, H, n, C, dh)
    vc = v.reshape(B, H, n, C, dh)
    i = jnp.arange(C)
    diff = (i[:, None] - i[None, :]).astype(jnp.float32)
    mask = diff >= 0 if include_diag else diff > 0
    lg = log_gamma[:, None, None]
    dmat = jnp.where(mask, jnp.exp(jnp.where(mask, diff, 0.0) * lg), 0.0)
    scores = jnp.einsum('bhnid,bhnjd->bhnij', qc, kc) * dmat[None, :, None]
    inner = jnp.einsum('bhnij,bhnjd->bhnid', scores, vc)
    k_decay = jnp.exp((C - 1 - i).astype(jnp.float32)[None, :] * log_gamma[:, None])
    q_decay = jnp.exp((i + 1).astype(jnp.float32)[None, :] * log_gamma[:, None])
    chunk_decay = jnp.exp(C * log_gamma)

    def step(state, qkv):
        q_, k_, v_ = qkv
        cross = jnp.einsum('bhid,bhde->bhie', q_, state) * q_decay[None, :, :, None]
        state = state * chunk_decay[None, :, None, None] + jnp.einsum(
            'bhjd,bhje->bhde', k_ * k_decay[None, :, :, None], v_)
        return state, cross

    xs = (jnp.moveaxis(qc, 2, 0), jnp.moveaxis(kc, 2, 0), jnp.moveaxis(vc, 2, 0))
    state0 = jnp.zeros((B, H, dh, dh), jnp.float32)
    _, cross = lax.scan(step, state0, xs)
    cross = jnp.moveaxis(cross, 0, 2)
    return (inner + cross).reshape(B, H, S, dh)


def setup_inputs(seed: int = 0) -> dict:
    key = jax.random.key(seed)
    ks = jax.random.split(key, 20)
    f32 = jnp.float32
    L = DEPTH

    def nrm(k, shape, fan_in):
        return jax.random.normal(k, shape, f32) * (fan_in ** -0.5)

    base = np.log(-np.log(1.0 - 2.0 ** (-5.0 - np.arange(RET_HEADS)))).astype(np.float32)
    return {
        'x': jax.random.normal(ks[0], (BATCH, SEQ, D_MODEL), f32),
        'c': jax.random.normal(ks[1], (BATCH, D_MODEL), f32),
        'w_ada': nrm(ks[2], (L, D_MODEL, N_MOD * D_MODEL), D_MODEL),
        'b_ada': 0.02 * jax.random.normal(ks[3], (L, N_MOD * D_MODEL), f32),
        'norm1_g': 1.0 + 0.02 * jax.random.normal(ks[4], (L, D_MODEL), f32),
        'w_in': nrm(ks[5], (L, D_MODEL, IN_WIDTH), D_MODEL),
        'pool_w': nrm(ks[6], (L, len(POOL_WINDOWS), POOL_GROUP, POOL_GROUP), POOL_GROUP),
        'pool_scale': 1.0 + 0.02 * jax.random.normal(ks[7], (L, POOL_WIDTH), f32),
        'ret_decay_fwd': jnp.asarray(base)[None, :] + 0.05 * jax.random.normal(ks[8], (L, RET_HEADS), f32),
        'ret_decay_bwd': jnp.asarray(base)[None, :] + 0.05 * jax.random.normal(ks[9], (L, RET_HEADS), f32),
        'w_out': nrm(ks[10], (L, MIX_WIDTH, D_MODEL), MIX_WIDTH),
        'norm2_g': 1.0 + 0.02 * jax.random.normal(ks[11], (L, D_MODEL), f32),
        'w_gate': nrm(ks[12], (L, D_MODEL, D_FF), D_MODEL),
        'w_up': nrm(ks[13], (L, D_MODEL, D_FF), D_MODEL),
        'w_down': nrm(ks[14], (L, D_FF, D_MODEL), D_FF),
        'final_g': 1.0 + 0.02 * jax.random.normal(ks[15], (D_MODEL,), f32),
    }


def reference(x, c, w_ada, b_ada, norm1_g, w_in, pool_w, pool_scale, ret_decay_fwd,
              ret_decay_bwd, w_out, norm2_g, w_gate, w_up, w_down, final_g):
    B, S, D = x.shape
    H, dh = RET_HEADS, RET_HEAD_DIM
    c_act = jax.nn.silu(c)

    def to_heads(t):
        return t.reshape(B, S, H, dh).transpose(0, 2, 1, 3).astype(jnp.float32)

    for l in range(DEPTH):
        mod = (c_act @ w_ada[l] + b_ada[l])[:, None, :]
        sh1, sc1, g1, sh2, sc2, g2 = jnp.split(mod, N_MOD, axis=-1)

        h = rmsnorm(x, norm1_g[l]) * (1.0 + sc1) + sh1
        proj = h @ w_in[l]
        o = POOL_WIDTH
        u_pool = proj[..., :o]
        q = proj[..., o:o + RET_WIDTH]
        k = proj[..., o + RET_WIDTH:o + 2 * RET_WIDTH]
        v = proj[..., o + 2 * RET_WIDTH:o + 3 * RET_WIDTH]
        g = proj[..., o + 3 * RET_WIDTH:]

        pooled = multi_scale_pool(u_pool).reshape(B, S, len(POOL_WINDOWS), POOL_GROUP)
        pool_out = jnp.einsum('bsgc,gcd->bsgd', pooled, pool_w[l].astype(jnp.float32))
        pool_out = (pool_out.reshape(B, S, POOL_WIDTH) * pool_scale[l]).astype(x.dtype)

        qh = rotary(to_heads(q)) * (dh ** -0.5)
        kh = rotary(to_heads(k))
        vh = to_heads(v)
        lg_f = -jnp.exp(ret_decay_fwd[l].astype(jnp.float32))
        lg_b = -jnp.exp(ret_decay_bwd[l].astype(jnp.float32))
        ret_f = retention_one_direction(qh, kh, vh, lg_f, True)
        ret_b = jnp.flip(retention_one_direction(
            jnp.flip(qh, 2), jnp.flip(kh, 2), jnp.flip(vh, 2), lg_b, False), 2)
        ret = ret_f + ret_b
        ret = ret * lax.rsqrt(jnp.mean(ret * ret, axis=-1, keepdims=True) + EPS)
        ret = ret.transpose(0, 2, 1, 3).reshape(B, S, RET_WIDTH).astype(x.dtype)
        ret_out = jax.nn.silu(g) * ret

        mixed = jnp.concatenate([pool_out, ret_out], axis=-1) @ w_out[l]
        x = x + g1 * mixed

        h2 = rmsnorm(x, norm2_g[l]) * (1.0 + sc2) + sh2
        ffn = (jax.nn.silu(h2 @ w_gate[l]) * (h2 @ w_up[l])) @ w_down[l]
        x = x + g2 * ffn

    return rmsnorm(x, final_g)
```

```cpp
#include <hip/hip_runtime.h>
#include <cstdio>
#include <cstdint>

#define LAS __attribute__((address_space(3)))
#define GAS __attribute__((address_space(1)))
typedef unsigned short bf16_t;
typedef short bf16x8 __attribute__((ext_vector_type(8)));
typedef short s16x4 __attribute__((ext_vector_type(4)));
typedef float f32x4 __attribute__((ext_vector_type(4)));
typedef float f32x2 __attribute__((ext_vector_type(2)));
typedef unsigned u32x4 __attribute__((ext_vector_type(4)));
typedef unsigned u32x2 __attribute__((ext_vector_type(2)));
typedef GAS unsigned gu32;

constexpr int BATCH = 8, SEQ = 2048, DM = 2048, MTOK = BATCH * SEQ;
constexpr int POOLW = 1024, NHEAD = 4, DH = 256, CHK = 128, NCHK = SEQ / CHK;
constexpr int FF = 5632, INW = 5120, NMODW = 6 * DM;
constexpr float EPS = 1e-6f;
constexpr int ADA_KC = 16;

constexpr size_t MiB = 1u << 20;
constexpr size_t WS_CTL = 0, CTL_ZERO_BYTES = 65536;
constexpr size_t WS_WIN = 1 * MiB, WS_WO = 21 * MiB, WS_WGU = 29 * MiB, WS_WD = 73 * MiB;
constexpr size_t WS_MODP = 95 * MiB, WS_MOD = 102 * MiB, WS_ROPE = 103 * MiB;
constexpr size_t WS_H = 170 * MiB, WS_CAT = 106 * MiB, WS_PROJ = 234 * MiB, WS_ACT = 234 * MiB, WS_END = 410 * MiB;
constexpr int CW_TMO = 0, CW_BAR = 4096;

constexpr int RING_BYTES = 143360, LDSCTL_OFF = RING_BYTES, LDS_BYTES = 147456;

namespace pg8 {
constexpr int BM = 256, BK = 64, HALF = 128, HTB = HALF * BK * 2, STAGE_BYTES = 8 * HTB, NXCD = 8, WGM = 4;
__host__ __device__ __forceinline__ int lds_byte(int r, int c) { const int st = (r >> 4) * 2 + (c >> 5), rr = r & 15, cc = c & 31, ob = rr * 64 + cc * 2; return st * 1024 + (ob ^ (((ob >> 9) & 1) << 5)); }
__host__ __device__ __forceinline__ void stage_rc(int b, int& R, int& C) { const int st = b / 1024, sb = b % 1024, swz = sb ^ (((sb >> 9) & 1) << 5); R = (st >> 1) * 16 + swz / 64; C = (st & 1) * 32 + (swz % 64) / 2; }
__host__ __device__ __forceinline__ int perm32(int rho) { const int n = rho >> 4, i = rho & 15; return 8 * (i >> 2) + 4 * n + (i & 3); }

struct Unit { int pm, pn; };
struct Gemm { const bf16_t* A; const bf16_t* Bt; int M, N, K; };

struct StaticOrder {
    int nM, nN, nwg, G, c;
    __host__ __device__ void init(int M, int N, int G_, int c_) { nM = M / BM; nN = N / BM; nwg = nM * nN; G = G_; c = c_; }
    __host__ __device__ bool next(int i, Unit& u) const {
        const long L = (long)i * G + c; if (L >= nwg) return false;
        int wgid = (int)L; { const int q = nwg / NXCD, r = nwg % NXCD, xcd = wgid % NXCD, off = wgid / NXCD; wgid = (xcd < r ? xcd * (q + 1) : r * (q + 1) + (xcd - r) * q) + off; }
        const int nig = WGM * nN, gid = wgid / nig, fm = gid * WGM, gsz = (nM - fm) < WGM ? (nM - fm) : WGM;
        u.pm = fm + ((wgid % nig) % gsz); u.pn = (wgid % nig) / gsz; return true;
    }
    __device__ __forceinline__ void a_ready(const Unit&) const {}
    __device__ __forceinline__ void done(const Unit&) const {}
};

__device__ __forceinline__ unsigned cvt_pk_bf16(float lo, float hi) { unsigned r; asm volatile("v_cvt_pk_bf16_f32 %0, %1, %2" : "=v"(r) : "v"(lo), "v"(hi)); return r; }
__device__ __forceinline__ float bflo_(unsigned w) { return __builtin_bit_cast(float, w << 16); }
__device__ __forceinline__ float bfhi_(unsigned w) { return __builtin_bit_cast(float, w & 0xffff0000u); }
__device__ __forceinline__ float fast_silu(float v) { return v * __builtin_amdgcn_rcpf(1.0f + __expf(-v)); }

struct EpiProj {
    static constexpr bool PERM = true, AFTER_DRAIN = false;
    bf16_t* O; const float* cosT; const float* sinT;
    __device__ __forceinline__ void operator()(f32x4 (&acc)[2][2][4][2], const Unit& u, int wr, int wc, int fr, int fq) const {
        const int row0 = u.pm * BM + wr * 64 + fr, col0 = u.pn * BM + wc * 32 + 8 * fq;
        const bool rot = (u.pn >= 4) && (u.pn < 12); const float qs = (u.pn < 8) ? 0.0625f : 1.0f;
        const int jj0 = wc * 32 + 8 * fq;
#pragma unroll
        for (int ai = 0; ai < 2; ++ai)
#pragma unroll
            for (int m = 0; m < 4; ++m) {
                const int row = row0 + ai * HALF + m * 16; bf16_t* rowp = O + (size_t)row * INW + col0;
                f32x4 a0 = acc[ai][0][m][0], a1 = acc[ai][0][m][1], b0 = acc[ai][1][m][0], b1 = acc[ai][1][m][1];
                if (rot) {
                    const int pos = row & (SEQ - 1);
                    const f32x4 c0 = *(const f32x4*)(cosT + pos * 128 + jj0), c1 = *(const f32x4*)(cosT + pos * 128 + jj0 + 4);
                    const f32x4 s0 = *(const f32x4*)(sinT + pos * 128 + jj0), s1 = *(const f32x4*)(sinT + pos * 128 + jj0 + 4);
                    const f32x4 o10 = (a0 * c0 - b0 * s0) * qs, o11 = (a1 * c1 - b1 * s1) * qs;
                    const f32x4 o20 = (a0 * s0 + b0 * c0) * qs, o21 = (a1 * s1 + b1 * c1) * qs;
                    a0 = o10; a1 = o11; b0 = o20; b1 = o21;
                }
                u32x4 w0, w1;
                w0.x = cvt_pk_bf16(a0[0], a0[1]); w0.y = cvt_pk_bf16(a0[2], a0[3]); w0.z = cvt_pk_bf16(a1[0], a1[1]); w0.w = cvt_pk_bf16(a1[2], a1[3]);
                w1.x = cvt_pk_bf16(b0[0], b0[1]); w1.y = cvt_pk_bf16(b0[2], b0[3]); w1.z = cvt_pk_bf16(b1[0], b1[1]); w1.w = cvt_pk_bf16(b1[2], b1[3]);
                *(u32x4*)(rowp) = w0; *(u32x4*)(rowp + HALF) = w1;
            }
    }
};
template <bool BASE_BF16> struct EpiRes {
    static constexpr bool PERM = true, AFTER_DRAIN = false;
    const void* base; bf16_t* out; const float* gv;
    __device__ __forceinline__ void operator()(f32x4 (&acc)[2][2][4][2], const Unit& u, int wr, int wc, int fr, int fq) const {
        const int col0 = u.pn * BM + wc * 32 + 8 * fq; const int b = u.pm >> 3;
        f32x4 g[2][2];
#pragma unroll
        for (int bj = 0; bj < 2; ++bj)
#pragma unroll
            for (int n = 0; n < 2; ++n) g[bj][n] = *(const f32x4*)(gv + (size_t)b * NMODW + col0 + bj * HALF + n * 4);
#pragma unroll
        for (int ai = 0; ai < 2; ++ai) {
            if constexpr (BASE_BF16) {
                u32x4 pre[4][2];
#pragma unroll
                for (int m = 0; m < 4; ++m) { const size_t off = (size_t)(u.pm * BM + ai * HALF + wr * 64 + m * 16 + fr) * DM + col0;
#pragma unroll
                    for (int bj = 0; bj < 2; ++bj) pre[m][bj] = *(const u32x4*)((const bf16_t*)base + off + bj * HALF); }
#pragma unroll
                for (int m = 0; m < 4; ++m) { const size_t off = (size_t)(u.pm * BM + ai * HALF + wr * 64 + m * 16 + fr) * DM + col0;
#pragma unroll
                    for (int bj = 0; bj < 2; ++bj) { const u32x4 p = pre[m][bj]; const f32x4 a0 = acc[ai][bj][m][0] * g[bj][0], a1 = acc[ai][bj][m][1] * g[bj][1];
                        u32x4 w; w.x = cvt_pk_bf16(bflo_(p.x) + a0[0], bfhi_(p.x) + a0[1]); w.y = cvt_pk_bf16(bflo_(p.y) + a0[2], bfhi_(p.y) + a0[3]);
                        w.z = cvt_pk_bf16(bflo_(p.z) + a1[0], bfhi_(p.z) + a1[1]); w.w = cvt_pk_bf16(bflo_(p.w) + a1[2], bfhi_(p.w) + a1[3]);
                        *(u32x4*)(out + off + bj * HALF) = w; } }
            } else {
                f32x4 pre[4][2][2];
#pragma unroll
                for (int m = 0; m < 4; ++m) { const size_t off = (size_t)(u.pm * BM + ai * HALF + wr * 64 + m * 16 + fr) * DM + col0;
#pragma unroll
                    for (int bj = 0; bj < 2; ++bj)
#pragma unroll
                        for (int n = 0; n < 2; ++n) pre[m][bj][n] = *(const f32x4*)((const float*)base + off + bj * HALF + n * 4); }
#pragma unroll
                for (int m = 0; m < 4; ++m) { const size_t off = (size_t)(u.pm * BM + ai * HALF + wr * 64 + m * 16 + fr) * DM + col0;
#pragma unroll
                    for (int bj = 0; bj < 2; ++bj) { const f32x4 v0 = pre[m][bj][0] + acc[ai][bj][m][0] * g[bj][0], v1 = pre[m][bj][1] + acc[ai][bj][m][1] * g[bj][1];
                        u32x4 w; w.x = cvt_pk_bf16(v0[0], v0[1]); w.y = cvt_pk_bf16(v0[2], v0[3]); w.z = cvt_pk_bf16(v1[0], v1[1]); w.w = cvt_pk_bf16(v1[2], v1[3]);
                        *(u32x4*)(out + off + bj * HALF) = w; } }
            }
            asm volatile("" ::: "memory");
        }
    }
};
struct EpiSwiGLU {
    static constexpr bool PERM = true, AFTER_DRAIN = false;
    bf16_t* O;
    __device__ __forceinline__ void operator()(f32x4 (&acc)[2][2][4][2], const Unit& u, int wr, int wc, int fr, int fq) const {
        const int row0 = u.pm * BM + wr * 64 + fr, col0 = u.pn * HALF + wc * 32 + 8 * fq;
#pragma unroll
        for (int ai = 0; ai < 2; ++ai)
#pragma unroll
            for (int m = 0; m < 4; ++m) {
                bf16_t* rowp = O + (size_t)(row0 + ai * HALF + m * 16) * FF + col0;
                const f32x4 g0 = acc[ai][0][m][0], g1 = acc[ai][0][m][1], u0 = acc[ai][1][m][0], u1 = acc[ai][1][m][1];
                f32x4 o0, o1;
#pragma unroll
                for (int e = 0; e < 4; ++e) { o0[e] = fast_silu(g0[e]) * u0[e]; o1[e] = fast_silu(g1[e]) * u1[e]; }
                u32x4 w; w.x = cvt_pk_bf16(o0[0], o0[1]); w.y = cvt_pk_bf16(o0[2], o0[3]); w.z = cvt_pk_bf16(o1[0], o1[1]); w.w = cvt_pk_bf16(o1[2], o1[3]);
                *(u32x4*)rowp = w;
            }
    }
};

template <class Epi, class Sched, bool ALIGN_EPI = false, bool SP2 = false>
__device__ __forceinline__ void gemm_phase(LAS unsigned char* lds, const Gemm g, const Sched& S, const Epi& E) {
    int tid = threadIdx.x; asm volatile("" : "+v"(tid));
    const int wid = __builtin_amdgcn_readfirstlane(tid >> 6), lane = tid & 63, wr = wid >> 2, wc = wid & 3, fr = lane & 15, fq = lane >> 4;
    const int K = g.K, nt = K / BK;
    unsigned voffA[2], voffB[2];
#pragma unroll
    for (int i = 0; i < 2; ++i) { int R, C; stage_rc(tid * 16 + i * 8192, R, C); const int Rb = Epi::PERM ? ((R & ~31) + perm32(R & 31)) : R;
        voffA[i] = (unsigned)(R * K + C) * 2u; voffB[i] = (unsigned)(Rb * K + C) * 2u; }
    const size_t kstep = (size_t)(BK * 2);
    const size_t hstep = (size_t)HALF * K * 2;
    const size_t tstep = 2 * hstep;
    const unsigned ldsw = (unsigned)wid * 1024u;
    const int aoff = lds_byte(wr * 64 + fr, fq * 8), boff = lds_byte(wc * 32 + fr, fq * 8);
#define PG8_SA(b, h) (((b) * 2 + (h)) * HTB)
#define PG8_SB(b, h) ((4 + (b) * 2 + (h)) * HTB)
#define PG8_STAGE(bufoff, gbase, voff) do { _Pragma("unroll") for (int _i = 0; _i < 2; ++_i) \
        __builtin_amdgcn_global_load_lds((const unsigned*)((const char*)(gbase) + (voff)[_i]), (LAS unsigned*)(lds + (bufoff) + ldsw + _i * 8192), 16, 0, 0); } while (0)
#define PG8_LDA(dst, b, h) do { _Pragma("unroll") for (int m = 0; m < 4; ++m) _Pragma("unroll") for (int k = 0; k < 2; ++k) dst[m][k] = *(const LAS bf16x8*)(lds + PG8_SA(b, h) + aoff + m * 2048 + k * 1024); } while (0)
#define PG8_LDB(dst, b, h) do { _Pragma("unroll") for (int n = 0; n < 2; ++n) _Pragma("unroll") for (int k = 0; k < 2; ++k) dst[n][k] = *(const LAS bf16x8*)(lds + PG8_SB(b, h) + boff + n * 2048 + k * 1024); } while (0)
#define PG8_MMA(ai, bj, At, Bt) do { __builtin_amdgcn_s_setprio(1); _Pragma("unroll") for (int k = 0; k < 2; ++k) _Pragma("unroll") for (int m = 0; m < 4; ++m) _Pragma("unroll") for (int n = 0; n < 2; ++n) \
        acc[ai][bj][m][n] = __builtin_amdgcn_mfma_f32_16x16x32_bf16(Bt[n][k], At[m][k], acc[ai][bj][m][n], 0, 0, 0); __builtin_amdgcn_s_setprio(0); } while (0)
#define PG8_WAIT_V(n) asm volatile("s_waitcnt vmcnt(" #n ")" ::: "memory")
#define PG8_WAIT_L(n) asm volatile("s_waitcnt lgkmcnt(" #n ")" ::: "memory")
#define PG8_BAR __builtin_amdgcn_s_barrier()
#define PG8_SCHED __builtin_amdgcn_sched_barrier(0)
    Unit cur, nxt; int ui = 0;
    if (!S.next(0, cur)) return;
    f32x4 acc[2][2][4][2];
#pragma unroll
    for (int a = 0; a < 2; ++a)
#pragma unroll
        for (int b = 0; b < 2; ++b)
#pragma unroll
            for (int m = 0; m < 4; ++m)
#pragma unroll
                for (int n = 0; n < 2; ++n) acc[a][b][m][n] = (f32x4){0.f, 0.f, 0.f, 0.f};
    bf16x8 At[4][2], B0[2][2], B1[2][2];
    const char* cA = (const char*)g.A + (size_t)cur.pm * tstep; const char* cB = (const char*)g.Bt + (size_t)cur.pn * tstep;
    S.a_ready(cur);
    if constexpr (SP2) {
        PG8_STAGE(PG8_SB(0, 0), cB, voffB); PG8_STAGE(PG8_SB(0, 1), cB + hstep, voffB); PG8_STAGE(PG8_SA(0, 0), cA, voffA); PG8_STAGE(PG8_SA(0, 1), cA + hstep, voffA);
        if (wr == 1) PG8_BAR;
        PG8_WAIT_V(2); PG8_BAR;
        PG8_STAGE(PG8_SB(1, 0), cB + kstep, voffB); PG8_STAGE(PG8_SA(1, 0), cA + kstep, voffA); PG8_STAGE(PG8_SB(1, 1), cB + hstep + kstep, voffB);
        PG8_WAIT_V(6); PG8_BAR;
    } else {
        PG8_STAGE(PG8_SB(0, 0), cB, voffB); PG8_STAGE(PG8_SA(0, 0), cA, voffA); PG8_STAGE(PG8_SB(0, 1), cB + hstep, voffB); PG8_STAGE(PG8_SA(0, 1), cA + hstep, voffA);
        if (wr == 1) PG8_BAR;
        PG8_WAIT_V(4); PG8_BAR;
        PG8_STAGE(PG8_SB(1, 0), cB + kstep, voffB); PG8_STAGE(PG8_SA(1, 0), cA + kstep, voffA); PG8_STAGE(PG8_SB(1, 1), cB + hstep + kstep, voffB);
        PG8_WAIT_V(6); PG8_BAR;
    }
    for (;;) {
        const bool has_next = S.next(ui + 1, nxt);
        const char* nA = has_next ? (const char*)g.A + (size_t)nxt.pm * tstep : cA; const char* nB = has_next ? (const char*)g.Bt + (size_t)nxt.pn * tstep : cB;
        for (int t = 0; t < nt; t += 2) {
            const bool last = (t == nt - 2);
            const char* a1 = cA + (size_t)(t + 1) * kstep;
            const char* a2 = last ? nA : cA + (size_t)(t + 2) * kstep; const char* b2 = last ? nB : cB + (size_t)(t + 2) * kstep;
            const char* a3 = a2 + kstep; const char* b3 = b2 + kstep;
            if (last && has_next) S.a_ready(nxt);
            if constexpr (SP2) {
            PG8_LDB(B0, 0, 0); PG8_LDB(B1, 0, 1); PG8_SCHED; PG8_LDA(At, 0, 0); PG8_STAGE(PG8_SA(1, 1), a1 + hstep, voffA);
            PG8_WAIT_V(8); PG8_WAIT_L(0); PG8_BAR; PG8_MMA(0, 0, At, B0); PG8_MMA(0, 1, At, B1); PG8_BAR; PG8_SCHED;
            PG8_LDA(At, 0, 1); PG8_STAGE(PG8_SB(0, 0), b2, voffB); PG8_STAGE(PG8_SB(0, 1), b2 + hstep, voffB); PG8_STAGE(PG8_SA(0, 0), a2, voffA);
            PG8_WAIT_V(8); PG8_WAIT_L(0); PG8_BAR; PG8_MMA(1, 0, At, B0); PG8_MMA(1, 1, At, B1); PG8_BAR; PG8_SCHED;
            PG8_LDB(B0, 1, 0); PG8_LDB(B1, 1, 1); PG8_SCHED; PG8_LDA(At, 1, 0); PG8_STAGE(PG8_SA(0, 1), a2 + hstep, voffA);
            PG8_WAIT_V(8); PG8_WAIT_L(0); PG8_BAR; PG8_MMA(0, 0, At, B0); PG8_MMA(0, 1, At, B1); PG8_BAR; PG8_SCHED;
            PG8_LDA(At, 1, 1); PG8_STAGE(PG8_SB(1, 0), b3, voffB); PG8_STAGE(PG8_SB(1, 1), b3 + hstep, voffB); PG8_STAGE(PG8_SA(1, 0), a3, voffA);
            PG8_WAIT_V(8); PG8_WAIT_L(0); PG8_BAR; PG8_MMA(1, 0, At, B0); PG8_MMA(1, 1, At, B1); PG8_BAR; PG8_SCHED;
            } else {
            PG8_LDB(B0, 0, 0); PG8_SCHED; PG8_LDA(At, 0, 0); PG8_STAGE(PG8_SA(1, 1), a1 + hstep, voffA);
            PG8_WAIT_L(8); PG8_BAR; PG8_WAIT_L(0); PG8_MMA(0, 0, At, B0); PG8_BAR; PG8_SCHED;
            PG8_LDB(B1, 0, 1); PG8_STAGE(PG8_SB(0, 0), b2, voffB);
            PG8_BAR; PG8_WAIT_L(0); PG8_MMA(0, 1, At, B1); PG8_BAR;
            PG8_LDA(At, 0, 1); PG8_STAGE(PG8_SA(0, 0), a2, voffA);
            PG8_BAR; PG8_WAIT_L(0); PG8_MMA(1, 0, At, B0); PG8_BAR; PG8_SCHED;
            PG8_STAGE(PG8_SB(0, 1), b2 + hstep, voffB);
            PG8_WAIT_V(6); PG8_BAR; PG8_MMA(1, 1, At, B1); PG8_BAR;
            PG8_LDB(B0, 1, 0); PG8_SCHED; PG8_LDA(At, 1, 0); PG8_STAGE(PG8_SA(0, 1), a2 + hstep, voffA);
            PG8_WAIT_L(8); PG8_BAR; PG8_WAIT_L(0); PG8_MMA(0, 0, At, B0); PG8_BAR; PG8_SCHED;
            PG8_LDB(B1, 1, 1); PG8_STAGE(PG8_SB(1, 0), b3, voffB);
            PG8_BAR; PG8_WAIT_L(0); PG8_MMA(0, 1, At, B1); PG8_BAR;
            PG8_LDA(At, 1, 1); PG8_STAGE(PG8_SA(1, 0), a3, voffA);
            PG8_BAR; PG8_WAIT_L(0); PG8_MMA(1, 0, At, B0); PG8_BAR; PG8_SCHED;
            PG8_STAGE(PG8_SB(1, 1), b3 + hstep, voffB);
            PG8_WAIT_V(6); PG8_BAR; PG8_MMA(1, 1, At, B1); PG8_BAR;
            }
        }
        if constexpr (ALIGN_EPI) { if (wr == 0) PG8_BAR; }
        if constexpr (!Epi::AFTER_DRAIN) { E(acc, cur, wr, wc, fr, fq); S.done(cur); }
        if (!has_next) break;
#pragma unroll
        for (int a = 0; a < 2; ++a)
#pragma unroll
            for (int b = 0; b < 2; ++b)
#pragma unroll
                for (int m = 0; m < 4; ++m)
#pragma unroll
                    for (int n = 0; n < 2; ++n) acc[a][b][m][n] = (f32x4){0.f, 0.f, 0.f, 0.f};
        cur = nxt; cA = nA; cB = nB; ++ui;
        if constexpr (ALIGN_EPI) { if (wr == 1) PG8_BAR; }
    }
    PG8_WAIT_V(0);
    if constexpr (!ALIGN_EPI) { if (wr == 0) PG8_BAR; }
    PG8_BAR;
#undef PG8_SA
#undef PG8_SB
#undef PG8_STAGE
#undef PG8_LDA
#undef PG8_LDB
#undef PG8_MMA
#undef PG8_WAIT_V
#undef PG8_WAIT_L
#undef PG8_BAR
#undef PG8_SCHED
}
}

#define RLX_AGENT __ATOMIC_RELAXED, __HIP_MEMORY_SCOPE_AGENT
#define LDS_WAIT() asm volatile("s_waitcnt lgkmcnt(0)" ::: "memory")
__device__ __forceinline__ unsigned f2bf(float f) { unsigned u = __builtin_bit_cast(unsigned, f); return (u + 0x7fffu + ((u >> 16) & 1u)) >> 16; }
__device__ __forceinline__ unsigned pk2(float lo, float hi) { return f2bf(lo) | (f2bf(hi) << 16); }
__device__ __forceinline__ float bflo(unsigned w) { return __builtin_bit_cast(float, w << 16); }
__device__ __forceinline__ float bfhi(unsigned w) { return __builtin_bit_cast(float, w & 0xffff0000u); }
__device__ __forceinline__ float ex2(float x) { return __builtin_amdgcn_exp2f(x); }
__device__ __forceinline__ float wave_sum(float v) {
#pragma unroll
    for (int o = 1; o < 64; o <<= 1) v += __shfl_xor(v, o);
    return v;
}

#define XB_TMO      128
#define XB_XCNT(j)  (256  + 64 * (j))
#define XB_XSUB(j)  (1280 + 64 * (j))
#define XB_XGEN(j)  (2304 + 64 * (j))
#define XB_TOP      3328
#define XB_TOPGEN   3392
#define XCD_BAR_WORDS 3456
#define XB_SPIN_CAP (1u << 18)
__device__ __forceinline__ unsigned xb_ld(unsigned* p)              { return __hip_atomic_load(p, __ATOMIC_RELAXED, __HIP_MEMORY_SCOPE_AGENT); }
__device__ __forceinline__ unsigned xb_add(unsigned* p, unsigned v) { return __hip_atomic_fetch_add(p, v, __ATOMIC_RELAXED, __HIP_MEMORY_SCOPE_AGENT); }
__device__ __forceinline__ unsigned xb_xcc_id() { return (unsigned)__builtin_amdgcn_s_getreg((3 << 11) | 20) & 0xFu; }
#define XB_SPIN(cond, bar) do { unsigned _sp = 0; while (cond) { __builtin_amdgcn_s_sleep(1); \
    if ((++_sp & 255u) == 0u) { if (xb_ld(&(bar)[XB_TMO])) break; if (_sp > XB_SPIN_CAP) { atomicAdd(&(bar)[XB_TMO], 1u); break; } } } } while (0)
struct XcdBarrier { unsigned* bar; unsigned x; volatile LAS unsigned* st; };
__device__ __forceinline__ XcdBarrier xcd_barrier_post(unsigned* bar, volatile LAS unsigned* st) {
    XcdBarrier b; b.bar = bar; b.x = xb_xcc_id(); b.st = st;
    if (threadIdx.x == 0) (void)xb_add(&bar[XB_XCNT(b.x)], 1u);
    return b;
}
__device__ __forceinline__ void xcd_barrier_complete(unsigned* bar, unsigned x, unsigned& nloc, unsigned& nx) {
    const unsigned G = gridDim.x * gridDim.y * gridDim.z;
    unsigned sum, cnt, mine, sp = 0u;
    for (;;) {
        sum = 0u; cnt = 0u; mine = 0u;
#pragma unroll
        for (unsigned j = 0; j < 16; ++j) { const unsigned c = xb_ld(&bar[XB_XCNT(j)]); sum += c; cnt += (c > 0u) ? 1u : 0u; mine = (j == x) ? c : mine; }
        if (sum == G) break;
        __builtin_amdgcn_s_sleep(1);
        if ((++sp & 255u) == 0u) { if (xb_ld(&bar[XB_TMO])) break; if (sp > XB_SPIN_CAP) { atomicAdd(&bar[XB_TMO], 1u); break; } }
    }
    nloc = mine > 0u ? mine : 1u; nx = cnt > 0u ? cnt : 1u;
}
__device__ __forceinline__ void xcd_barrier(const XcdBarrier& b) {
    asm volatile("s_waitcnt vmcnt(0)" ::: "memory");
    __syncthreads();
    if (threadIdx.x == 0) {
        unsigned* bar = b.bar;
        __builtin_amdgcn_s_waitcnt(0);
        unsigned nloc = b.st[0], nx = b.st[1];
        if (nloc == 0u) { xcd_barrier_complete(bar, b.x, nloc, nx); b.st[0] = nloc; b.st[1] = nx; }
        const unsigned old = xb_add(&bar[XB_XSUB(b.x)], 1u);
        const unsigned gen = old / nloc;
        if (old + 1u == (gen + 1u) * nloc) {
            __builtin_amdgcn_fence(__ATOMIC_RELEASE, "agent");
            asm volatile("s_waitcnt vmcnt(0)" ::: "memory");
            const unsigned og = xb_add(&bar[XB_TOP], 1u);
            const unsigned tg = og / nx;
            if (og + 1u == (tg + 1u) * nx) xb_add(&bar[XB_TOPGEN], 1u);
            else XB_SPIN(xb_ld(&bar[XB_TOPGEN]) == tg, bar);
            __builtin_amdgcn_fence(__ATOMIC_ACQUIRE, "agent");
            xb_add(&bar[XB_XGEN(b.x)], 1u);
            asm volatile("s_waitcnt vmcnt(0)" ::: "memory");
        } else {
            XB_SPIN(xb_ld(&bar[XB_XGEN(b.x)]) == gen, bar);
            __builtin_amdgcn_fence(__ATOMIC_ACQUIRE, "agent");
            asm volatile("s_waitcnt vmcnt(0)" ::: "memory");
        }
    }
    __syncthreads();
}

struct Ctx { LAS unsigned char* lds; int tid, lane, wave, vcu, G; };

__host__ __device__ __forceinline__ int perm5(int n) { return 8 * ((n >> 2) & 3) + 4 * ((n >> 4) & 1) + (n & 3); }
template <bool PERMN, bool PERMK>
__device__ __forceinline__ void p0_transpose_item(const float* W, int ldw, bf16_t* WT, int kdst, int k0, int n_src0, int drow0, LAS float* scr, int lane) {
#pragma unroll 8
    for (int i = 0; i < 32; ++i) { const int kk = 2 * i + (lane >> 5); scr[kk * 33 + (lane & 31)] = W[(size_t)(k0 + kk) * ldw + n_src0 + (lane & 31)]; }
    LDS_WAIT(); asm volatile("" ::: "memory");
    const int c = lane & 7;
#pragma unroll
    for (int j = 0; j < 4; ++j) { const int n = (lane >> 3) + 8 * j;
        float v[8];
#pragma unroll
        for (int e = 0; e < 8; ++e) { const int kk = PERMK ? (32 * (c >> 2) + 16 * (e >> 2) + 4 * (c & 3) + (e & 3)) : (8 * c + e); v[e] = scr[kk * 33 + n]; }
        u32x4 o; o.x = pk2(v[0], v[1]); o.y = pk2(v[2], v[3]); o.z = pk2(v[4], v[5]); o.w = pk2(v[6], v[7]);
        *(GAS u32x4*)(WT + (size_t)(drow0 + (PERMN ? perm5(n) : n)) * kdst + k0 + 8 * c) = o; }
    LDS_WAIT(); asm volatile("" ::: "memory");
}

struct P0Args { const float *c, *w_ada, *w_in, *pool_w, *pool_scale, *w_out, *w_gate, *w_up, *w_down; bf16_t *WinT, *WoT, *WguT, *WdT; float *modp, *cosT, *sinT; };

__device__ __forceinline__ void p0_prologue(const Ctx& F, const P0Args& A) {
    const int tid = F.tid, lane = F.lane, w = F.wave;
    {
        LAS float* cact = (LAS float*)(F.lds);
        LAS float* red = (LAS float*)(F.lds + 4096);
        for (int it = F.vcu; it < 48 * ADA_KC; it += F.G) {
            const int cg = it % 48, kc = it / 48;
            for (int i = tid; i < 1024; i += 512) { const int kk = i >> 3, b = i & 7; const float cv = A.c[b * DM + kc * 128 + kk]; cact[kk * 8 + b] = cv / (1.0f + __expf(-cv)); }
            __syncthreads();
            f32x4 acc[8];
#pragma unroll
            for (int b = 0; b < 8; ++b) acc[b] = (f32x4){0.f, 0.f, 0.f, 0.f};
            const float* wp = A.w_ada + (size_t)(kc * 128 + w * 16) * NMODW + cg * 256 + lane * 4;
#pragma unroll 4
            for (int r = 0; r < 16; ++r) {
                const f32x4 wv = *(const f32x4*)(wp + (size_t)r * NMODW);
                const f32x4 ca = *(const LAS f32x4*)(cact + (w * 16 + r) * 8), cb = *(const LAS f32x4*)(cact + (w * 16 + r) * 8 + 4);
                acc[0] += ca[0] * wv; acc[1] += ca[1] * wv; acc[2] += ca[2] * wv; acc[3] += ca[3] * wv;
                acc[4] += cb[0] * wv; acc[5] += cb[1] * wv; acc[6] += cb[2] * wv; acc[7] += cb[3] * wv;
            }
#pragma unroll
            for (int b = 0; b < 8; ++b) *(LAS f32x4*)(red + (w * 8 + b) * 256 + lane * 4) = acc[b];
            __syncthreads();
            { const int b = tid >> 6, col = (tid & 63) * 4; f32x4 s = (f32x4){0.f, 0.f, 0.f, 0.f};
#pragma unroll
              for (int ww = 0; ww < 8; ++ww) s += *(const LAS f32x4*)(red + (ww * 8 + b) * 256 + col);
              *(f32x4*)(A.modp + (size_t)(kc * 8 + b) * NMODW + cg * 256 + col) = s; }
            __syncthreads();
        }
    }
    {
        const int fr = lane & 15, g4 = lane >> 4;
        for (int u = F.vcu; u < 256; u += F.G) {
            const int g = u >> 6, k0 = (u & 63) * 32;
            f32x4 acc[2][2];
#pragma unroll
            for (int kt = 0; kt < 2; ++kt)
#pragma unroll
                for (int nt = 0; nt < 2; ++nt) acc[kt][nt] = (f32x4){0.f, 0.f, 0.f, 0.f};
            const float* ap = A.w_in + (size_t)(k0 + fr) * INW + g * 256 + 8 * g4;
            const float* bp = A.pool_w + (size_t)(g * 256 + 8 * g4) * 256 + 32 * w + fr;
#pragma unroll 2
            for (int s = 0; s < 8; ++s) {
                bf16x8 af[2], bq[2];
#pragma unroll
                for (int kt = 0; kt < 2; ++kt) { const f32x4 a0 = *(const f32x4*)(ap + (size_t)(16 * kt) * INW + 32 * s), a1 = *(const f32x4*)(ap + (size_t)(16 * kt) * INW + 32 * s + 4);
                    u32x4 t; t.x = pk2(a0[0], a0[1]); t.y = pk2(a0[2], a0[3]); t.z = pk2(a1[0], a1[1]); t.w = pk2(a1[2], a1[3]); af[kt] = __builtin_bit_cast(bf16x8, t); }
#pragma unroll
                for (int nt = 0; nt < 2; ++nt) { float bv[8];
#pragma unroll
                    for (int e = 0; e < 8; ++e) bv[e] = bp[(size_t)(32 * s + e) * 256 + 16 * nt];
                    u32x4 t; t.x = pk2(bv[0], bv[1]); t.y = pk2(bv[2], bv[3]); t.z = pk2(bv[4], bv[5]); t.w = pk2(bv[6], bv[7]); bq[nt] = __builtin_bit_cast(bf16x8, t); }
#pragma unroll
                for (int kt = 0; kt < 2; ++kt)
#pragma unroll
                    for (int nt = 0; nt < 2; ++nt) acc[kt][nt] = __builtin_amdgcn_mfma_f32_16x16x32_bf16(af[kt], bq[nt], acc[kt][nt], 0, 0, 0);
            }
#pragma unroll
            for (int nt = 0; nt < 2; ++nt) { const int n = 32 * w + 16 * nt + fr; const float sc = A.pool_scale[g * 256 + n];
#pragma unroll
                for (int kt = 0; kt < 2; ++kt) { u32x2 o; o.x = pk2(acc[kt][nt][0] * sc, acc[kt][nt][1] * sc); o.y = pk2(acc[kt][nt][2] * sc, acc[kt][nt][3] * sc);
                    *(GAS u32x2*)(A.WinT + (size_t)(g * 256 + n) * DM + k0 + 16 * kt + 4 * g4) = o; } }
        }
    }
    for (int idx = F.vcu * 512 + tid; idx < SEQ * 128; idx += F.G * 512) {
        const int pos = idx >> 7, j = idx & 127;
        const float t = (float)j / 127.0f;
        const float inv = ex2(-t * 13.287712379549449f);
        const double ang = (double)((float)pos * inv);
        const double kq = __builtin_rint(ang * 0.63661977236758134308);
        const double r = (ang - kq * 1.57079632679489655800) - kq * 6.12323399573676603587e-17;
        const double r2 = r * r;
        const double sn = r * (1.0 + r2 * (-1.0 / 6 + r2 * (1.0 / 120 + r2 * (-1.0 / 5040 + r2 * (1.0 / 362880 + r2 * (-1.0 / 39916800 + r2 * (1.0 / 6227020800.0)))))));
        const double cs = 1.0 + r2 * (-0.5 + r2 * (1.0 / 24 + r2 * (-1.0 / 720 + r2 * (1.0 / 40320 + r2 * (-1.0 / 3628800 + r2 * (1.0 / 479001600.0 + r2 * (-1.0 / 87178291200.0)))))));
        const int qd = ((int)kq) & 3;
        const double c = (qd == 0) ? cs : (qd == 1) ? -sn : (qd == 2) ? -cs : sn;
        const double s = (qd == 0) ? sn : (qd == 1) ? cs : (qd == 2) ? -sn : -cs;
        A.cosT[idx] = (float)c; A.sinT[idx] = (float)s;
    }
    {
        LAS float* scr = (LAS float*)(F.lds + w * 16384);
        const int gw = F.vcu * 8 + w, NGW = F.G * 8;
        constexpr int I_IN = (DM / 64) * ((INW - POOLW) / 32), I_O = (DM / 64) * (DM / 32), I_G = (DM / 64) * (FF / 32), I_D = (FF / 64) * (DM / 32);
        constexpr int NITEMS = I_IN + I_O + 2 * I_G + I_D;
        for (int it = gw; it < NITEMS; it += NGW) {
            int r = it;
            if (r < I_IN) { const int nblk = (INW - POOLW) / 32, kb = r / nblk, nb = r % nblk; if (nb >= 96) p0_transpose_item<true, false>(A.w_in + POOLW, INW, A.WinT, DM, kb * 64, nb * 32, POOLW + nb * 32, scr, lane); else p0_transpose_item<false, false>(A.w_in + POOLW, INW, A.WinT, DM, kb * 64, nb * 32, POOLW + nb * 32, scr, lane); continue; } r -= I_IN;
            if (r < I_O) { const int nblk = DM / 32, kb = r / nblk, nb = r % nblk; if (kb >= 16) p0_transpose_item<false, true>(A.w_out, DM, A.WoT, DM, kb * 64, nb * 32, nb * 32, scr, lane); else p0_transpose_item<false, false>(A.w_out, DM, A.WoT, DM, kb * 64, nb * 32, nb * 32, scr, lane); continue; } r -= I_O;
            if (r < I_G) { const int nblk = FF / 32, kb = r / nblk, nb = r % nblk; p0_transpose_item<false, false>(A.w_gate, FF, A.WguT, DM, kb * 64, nb * 32, 256 * (nb >> 2) + 32 * (nb & 3), scr, lane); continue; } r -= I_G;
            if (r < I_G) { const int nblk = FF / 32, kb = r / nblk, nb = r % nblk; p0_transpose_item<false, false>(A.w_up, FF, A.WguT, DM, kb * 64, nb * 32, 256 * (nb >> 2) + 128 + 32 * (nb & 3), scr, lane); continue; } r -= I_G;
            { const int nblk = DM / 32, kb = r / nblk, nb = r % nblk; p0_transpose_item<false, false>(A.w_down, DM, A.WdT, FF, kb * 64, nb * 32, nb * 32, scr, lane); }
        }
    }
}

template <int MODE>
__device__ __forceinline__ void norm_mod_phase(const Ctx& F, const float* src, bf16_t* dst, const float* gnorm, const float* modp, const float* b_ada, float* mod, int sh_idx, int sc_idx) {
    LAS float* Av = (LAS float*)(F.lds); LAS float* Bv = (LAS float*)(F.lds + 8192);
    for (int blk = F.vcu; blk < MTOK / 64; blk += F.G) {
        const int b = blk >> 5;
        const int row0 = blk * 64 + F.wave * 8;
        f32x4 v[8], vn[8];
        { const GAS f32x4* xr = (const GAS f32x4*)(src + (size_t)row0 * DM) + F.lane;
#pragma unroll
          for (int j = 0; j < 8; ++j) v[j] = xr[64 * j]; }
        __syncthreads();
        for (int k = F.tid; k < DM; k += 512) {
            float sc, sh;
            if (MODE == 0) {
                sc = b_ada[sc_idx * DM + k]; sh = b_ada[sh_idx * DM + k];
#pragma unroll 4
                for (int kc = 0; kc < ADA_KC; ++kc) { sc += modp[(size_t)(kc * 8 + b) * NMODW + sc_idx * DM + k]; sh += modp[(size_t)(kc * 8 + b) * NMODW + sh_idx * DM + k]; }
            } else { sc = mod[(size_t)b * NMODW + sc_idx * DM + k]; sh = mod[(size_t)b * NMODW + sh_idx * DM + k]; }
            Av[k] = gnorm[k] * (1.0f + sc); Bv[k] = sh;
        }
        if (MODE == 0) {
            if (F.tid < 384) { const int idx = blk * 384 + F.tid, bb = idx / NMODW, n = idx % NMODW; float s = b_ada[n];
#pragma unroll 4
                for (int kc = 0; kc < ADA_KC; ++kc) s += modp[(size_t)(kc * 8 + bb) * NMODW + n];
                mod[idx] = s; }
        }
        __syncthreads();
        {
            for (int i = 0; i < 8; ++i) {
                const int row = row0 + i;
                if (i < 7) { const GAS f32x4* xr = (const GAS f32x4*)(src + (size_t)(row + 1) * DM) + F.lane;
#pragma unroll
                    for (int j = 0; j < 8; ++j) vn[j] = xr[64 * j]; }
                float s = 0.f;
#pragma unroll
                for (int j = 0; j < 8; ++j) s += (v[j][0] * v[j][0] + v[j][1] * v[j][1]) + (v[j][2] * v[j][2] + v[j][3] * v[j][3]);
                const float rstd = 1.0f / sqrtf(wave_sum(s) * (1.0f / DM) + EPS);
                GAS u32x2* o8 = (GAS u32x2*)(dst + (size_t)row * DM) + F.lane;
#pragma unroll
                for (int j = 0; j < 8; ++j) { const f32x4 a = *(const LAS f32x4*)(Av + 4 * F.lane + 256 * j), bb = *(const LAS f32x4*)(Bv + 4 * F.lane + 256 * j);
                    const f32x4 o = v[j] * rstd * a + bb; u32x2 wv; wv.x = pk2(o[0], o[1]); wv.y = pk2(o[2], o[3]); o8[64 * j] = wv; }
#pragma unroll
                for (int j = 0; j < 8; ++j) v[j] = vn[j];
            }
        }
    }
}

__device__ __forceinline__ void norm_mod_bf16_phase(const Ctx& F, const bf16_t* src, bf16_t* dst, const float* gnorm, const float* mod, int sh_idx, int sc_idx) {
    LAS float* Av = (LAS float*)(F.lds); LAS float* Bv = (LAS float*)(F.lds + 8192);
    for (int blk = F.vcu; blk < MTOK / 64; blk += F.G) {
        const int b = blk >> 5;
        __syncthreads();
        for (int k = F.tid; k < DM; k += 512) { const float sc = mod[(size_t)b * NMODW + sc_idx * DM + k], sh = mod[(size_t)b * NMODW + sh_idx * DM + k]; Av[k] = gnorm[k] * (1.0f + sc); Bv[k] = sh; }
        __syncthreads();
        const int row0 = blk * 64 + F.wave * 8;
        u32x4 v[4], vn[4];
        { const GAS u32x4* xr = (const GAS u32x4*)(src + (size_t)row0 * DM) + F.lane;
#pragma unroll
          for (int j = 0; j < 4; ++j) v[j] = xr[64 * j]; }
        for (int i = 0; i < 8; ++i) {
            const int row = row0 + i;
            if (i < 7) { const GAS u32x4* xr = (const GAS u32x4*)(src + (size_t)(row + 1) * DM) + F.lane;
#pragma unroll
                for (int j = 0; j < 4; ++j) vn[j] = xr[64 * j]; }
            float f[4][8]; float s = 0.f;
#pragma unroll
            for (int j = 0; j < 4; ++j) { f[j][0] = bflo(v[j].x); f[j][1] = bfhi(v[j].x); f[j][2] = bflo(v[j].y); f[j][3] = bfhi(v[j].y); f[j][4] = bflo(v[j].z); f[j][5] = bfhi(v[j].z); f[j][6] = bflo(v[j].w); f[j][7] = bfhi(v[j].w);
#pragma unroll
                for (int e = 0; e < 8; ++e) s += f[j][e] * f[j][e]; }
            const float rstd = 1.0f / sqrtf(wave_sum(s) * (1.0f / DM) + EPS);
            GAS u32x4* o16 = (GAS u32x4*)(dst + (size_t)row * DM) + F.lane;
#pragma unroll
            for (int j = 0; j < 4; ++j) { const LAS float* ap = Av + 8 * F.lane + 512 * j; const LAS float* bp = Bv + 8 * F.lane + 512 * j;
                const f32x4 a0 = *(const LAS f32x4*)ap, a1 = *(const LAS f32x4*)(ap + 4), b0 = *(const LAS f32x4*)bp, b1 = *(const LAS f32x4*)(bp + 4);
                u32x4 w; w.x = pk2(f[j][0] * rstd * a0[0] + b0[0], f[j][1] * rstd * a0[1] + b0[1]); w.y = pk2(f[j][2] * rstd * a0[2] + b0[2], f[j][3] * rstd * a0[3] + b0[3]);
                w.z = pk2(f[j][4] * rstd * a1[0] + b1[0], f[j][5] * rstd * a1[1] + b1[1]); w.w = pk2(f[j][6] * rstd * a1[2] + b1[2], f[j][7] * rstd * a1[3] + b1[3]);
                o16[64 * j] = w; }
#pragma unroll
            for (int j = 0; j < 4; ++j) v[j] = vn[j];
        }
    }
}

__device__ __forceinline__ void final_norm_phase(const Ctx& F, const bf16_t* src, float* out, const float* g) {
    const int gw = F.vcu * 8 + F.wave, NGW = F.G * 8;
    static_assert(MTOK % 2048 == 0, "rows per wave");
    for (int r0 = gw; r0 < MTOK; r0 += NGW * 8) {
        u32x4 v[8][4];
#pragma unroll
        for (int i = 0; i < 8; ++i) { const GAS u32x4* xr = (const GAS u32x4*)(src + (size_t)(r0 + i * NGW) * DM) + F.lane;
#pragma unroll
            for (int j = 0; j < 4; ++j) v[i][j] = (r0 + i * NGW < MTOK) ? xr[64 * j] : (u32x4){0u, 0u, 0u, 0u}; }
#pragma unroll
        for (int i = 0; i < 8; ++i) {
            const int row = r0 + i * NGW;
            if (row < MTOK) {
                float f[4][8]; float s = 0.f;
#pragma unroll
                for (int j = 0; j < 4; ++j) { f[j][0] = bflo(v[i][j].x); f[j][1] = bfhi(v[i][j].x); f[j][2] = bflo(v[i][j].y); f[j][3] = bfhi(v[i][j].y); f[j][4] = bflo(v[i][j].z); f[j][5] = bfhi(v[i][j].z); f[j][6] = bflo(v[i][j].w); f[j][7] = bfhi(v[i][j].w);
#pragma unroll
                    for (int e = 0; e < 8; ++e) s += f[j][e] * f[j][e]; }
                const float rstd = 1.0f / sqrtf(wave_sum(s) * (1.0f / DM) + EPS);
                float* orow = out + (size_t)row * DM + 8 * F.lane;
#pragma unroll
                for (int j = 0; j < 4; ++j) { const f32x4 g0 = *(const f32x4*)(g + 8 * F.lane + 512 * j), g1 = *(const f32x4*)(g + 8 * F.lane + 512 * j + 4);
                    f32x4 o0, o1;
#pragma unroll
                    for (int e = 0; e < 4; ++e) { o0[e] = f[j][e] * rstd * g0[e]; o1[e] = f[j][4 + e] * rstd * g1[e]; }
                    *(f32x4*)(orow + 512 * j) = o0; *(f32x4*)(orow + 512 * j + 4) = o1; }
            }
        }
    }
}

__device__ __forceinline__ void pool_phase(const Ctx& F, const bf16_t* proj, bf16_t* cat) {
    LAS unsigned char* T = F.lds;
    for (int blk = F.vcu; blk < MTOK / 64; blk += F.G) {
        const int b = blk >> 5, tb = (blk & 31) * 64;
        for (int hc = 0; hc < 2; ++hc) {
            int tid = F.tid; asm volatile("" : "+v"(tid));
            __syncthreads();
            { u32x4 r[10];
#pragma unroll
              for (int i = 0; i < 10; ++i) { const int idx = tid + 512 * i, row = idx >> 6, chn = idx & 63, gt = tb - 8 + row;
                  r[i] = (u32x4){0u, 0u, 0u, 0u};
                  if (gt >= 0 && gt < SEQ) r[i] = *(const u32x4*)(proj + ((size_t)b * SEQ + gt) * INW + hc * 512 + chn * 8); }
#pragma unroll
              for (int i = 0; i < 10; ++i) { const int idx = tid + 512 * i; *(LAS u32x4*)(T + idx * 16) = r[i]; } }
            __syncthreads();
            const int cgl = tid & 63, rg = tid >> 6;
            const int half = 1 << (hc * 2 + (cgl >> 5));
            const int t0 = tb + rg * 8;
            LAS unsigned char* col = T + cgl * 16;
            float S[8];
#pragma unroll
            for (int e = 0; e < 8; ++e) S[e] = 0.f;
            { const int lo = (t0 - half) > 0 ? (t0 - half) : 0, hi = (t0 + half) < SEQ ? (t0 + half) : SEQ;
              for (int j = lo; j < hi; ++j) { const u32x4 v = *(const LAS u32x4*)(col + (j - tb + 8) * 1024);
                  S[0] += bflo(v.x); S[1] += bfhi(v.x); S[2] += bflo(v.y); S[3] += bfhi(v.y); S[4] += bflo(v.z); S[5] += bfhi(v.z); S[6] += bflo(v.w); S[7] += bfhi(v.w); } }
#pragma unroll
            for (int i = 0; i < 8; ++i) {
                const int t = t0 + i;
                const int lo = (t - half) > 0 ? (t - half) : 0, hi = (t + half) < SEQ ? (t + half) : SEQ;
                const float rc = 1.0f / (float)(hi - lo);
                const u32x4 v = *(const LAS u32x4*)(col + (t - tb + 8) * 1024);
                u32x4 o;
                o.x = pk2(S[0] * rc - bflo(v.x), S[1] * rc - bfhi(v.x)); o.y = pk2(S[2] * rc - bflo(v.y), S[3] * rc - bfhi(v.y));
                o.z = pk2(S[4] * rc - bflo(v.z), S[5] * rc - bfhi(v.z)); o.w = pk2(S[6] * rc - bflo(v.w), S[7] * rc - bfhi(v.w));
                *(u32x4*)(cat + ((size_t)b * SEQ + t) * DM + hc * 512 + cgl * 8) = o;
                if (t + half < SEQ) { const u32x4 a = *(const LAS u32x4*)(col + (t + half - tb + 8) * 1024);
                    S[0] += bflo(a.x); S[1] += bfhi(a.x); S[2] += bflo(a.y); S[3] += bfhi(a.y); S[4] += bflo(a.z); S[5] += bfhi(a.z); S[6] += bflo(a.w); S[7] += bfhi(a.w); }
                if (t - half >= 0) { const u32x4 a = *(const LAS u32x4*)(col + (t - half - tb + 8) * 1024);
                    S[0] -= bflo(a.x); S[1] -= bfhi(a.x); S[2] -= bflo(a.y); S[3] -= bfhi(a.y); S[4] -= bflo(a.z); S[5] -= bfhi(a.z); S[6] -= bflo(a.w); S[7] -= bfhi(a.w); }
            }
        }
    }
    __syncthreads();
}

constexpr int RS = 544;
constexpr int RSV = 160;
__device__ __forceinline__ bf16x8 tr_pair(LAS unsigned char* p0, LAS unsigned char* p1) {
    const s16x4 a = __builtin_amdgcn_ds_read_tr16_b64_v4i16((LAS s16x4*)p0), b = __builtin_amdgcn_ds_read_tr16_b64_v4i16((LAS s16x4*)p1);
    return __builtin_shufflevector(a, b, 0, 1, 2, 3, 4, 5, 6, 7);
}
__device__ __forceinline__ bf16x8 pack8(const f32x4 a, const f32x4 b) {
    u32x4 w; w.x = pk2(a[0], a[1]); w.y = pk2(a[2], a[3]); w.z = pk2(b[0], b[1]); w.w = pk2(b[2], b[3]);
    return __builtin_bit_cast(bf16x8, w);
}

__device__ __forceinline__ void ret_chain_phase(const Ctx& F, const bf16_t* proj, bf16_t* yp, const float* dec_f, const float* dec_b) {
    LAS unsigned char* KT = F.lds; LAS unsigned char* VT = F.lds + 128 * RS; LAS unsigned char* ST = F.lds + 128 * RS + 128 * RSV;
    const int w = F.wave;
    for (int ch = F.vcu; ch < 256; ch += F.G) {
        int tid = F.tid; asm volatile("" : "+v"(tid));
        const int lane = tid & 63, fr = lane & 15, g4 = lane >> 4, q = fr >> 2, p = fr & 3;
        const int bh = ch >> 3, b = bh >> 2, h = bh & 3, dir = (ch >> 2) & 1, slab = ch & 3;
        const float lg = -__expf(dir ? dec_b[h] : dec_f[h]);
        const float l2 = lg * 1.44269504088896341f;
        f32x4 S[2][4];
#pragma unroll
        for (int dd = 0; dd < 2; ++dd)
#pragma unroll
            for (int et = 0; et < 4; ++et) S[dd][et] = (f32x4){0.f, 0.f, 0.f, 0.f};
        __syncthreads();
        for (int i = tid; i < 64 * RS / 16; i += 512) *(LAS u32x4*)(ST + i * 16) = (u32x4){0u, 0u, 0u, 0u};
        const float cdec = ex2(128.0f * l2);
        const int krow = tid >> 5, kc16 = tid & 31, vrow = tid >> 3, vc16 = tid & 7;
        u32x4 kreg[8], vreg[2]; bf16x8 qreg[8];
#define RC_PTRS(STEP) const int n_ = dir ? (NCHK - 1 - (STEP)) : (STEP); const size_t mm = (size_t)b * SEQ + (size_t)n_ * CHK; \
            const bf16_t* kp_ = proj + (mm + krow) * INW + 2048 + 256 * h + kc16 * 8; \
            const bf16_t* vp_ = proj + (mm + vrow) * INW + 3072 + 256 * h + 64 * slab + vc16 * 8; \
            const bf16_t* qp_ = proj + (mm + 16 * w + fr) * INW + 1024 + 256 * h + 8 * g4;
#define RC_LOAD_K(I0) do { kreg[(I0)] = *(const u32x4*)(kp_ + (size_t)(16 * (I0)) * INW); kreg[(I0) + 1] = *(const u32x4*)(kp_ + (size_t)(16 * ((I0) + 1)) * INW); } while (0)
#define RC_LOAD_Q(S0) do { qreg[(S0)] = *(const bf16x8*)(qp_ + 32 * (S0)); qreg[(S0) + 1] = *(const bf16x8*)(qp_ + 32 * ((S0) + 1)); } while (0)
#define RC_LOAD_V() do { vreg[0] = *(const u32x4*)(vp_); vreg[1] = *(const u32x4*)(vp_ + (size_t)64 * INW); } while (0)
        { RC_PTRS(0); RC_LOAD_K(0); RC_LOAD_K(2); RC_LOAD_K(4); RC_LOAD_K(6); RC_LOAD_V(); RC_LOAD_Q(0); RC_LOAD_Q(2); RC_LOAD_Q(4); RC_LOAD_Q(6); }
        for (int step = 0; step < NCHK; ++step) {
            const int n = dir ? (NCHK - 1 - step) : step;
            const size_t m0 = (size_t)b * SEQ + (size_t)n * CHK;
#pragma unroll
            for (int i = 0; i < 8; ++i) *(LAS u32x4*)(KT + (krow + 16 * i) * RS + kc16 * 16) = kreg[i];
#pragma unroll
            for (int i = 0; i < 2; ++i) { const int row = vrow + 64 * i; const u32x4 v = vreg[i];
                const float kd = ex2((float)(dir ? row : (CHK - 1 - row)) * l2);
                u32x4 o; o.x = pk2(bflo(v.x) * kd, bfhi(v.x) * kd); o.y = pk2(bflo(v.y) * kd, bfhi(v.y) * kd); o.z = pk2(bflo(v.z) * kd, bfhi(v.z) * kd); o.w = pk2(bflo(v.w) * kd, bfhi(v.w) * kd);
                *(LAS u32x4*)(VT + row * RSV + vc16 * 16) = o; }
            bf16x8 qf[8];
#pragma unroll
            for (int s = 0; s < 8; ++s) qf[s] = qreg[s];
            __syncthreads();
            const bool more = step + 1 < NCHK;
            RC_PTRS(more ? step + 1 : step);
            { f32x4 y[4];
              bf16x8 sfb[2][8];
#pragma unroll
              for (int s = 0; s < 8; ++s) sfb[0][s] = *(const LAS bf16x8*)(ST + (fr) * RS + (32 * s + 8 * g4) * 2);
#pragma unroll
              for (int et = 0; et < 4; ++et) { y[et] = (f32x4){0.f, 0.f, 0.f, 0.f};
                  if (et < 3) {
#pragma unroll
                      for (int s = 0; s < 8; ++s) sfb[(et + 1) & 1][s] = *(const LAS bf16x8*)(ST + (16 * (et + 1) + fr) * RS + (32 * s + 8 * g4) * 2); }
#pragma unroll
                  for (int s = 0; s < 8; ++s) y[et] = __builtin_amdgcn_mfma_f32_16x16x32_bf16(sfb[et & 1][s], qf[s], y[et], 0, 0, 0);
                  if (more) RC_LOAD_K(2 * et);
                  __builtin_amdgcn_sched_barrier(0); }
              const int ii = 16 * w + fr;
              const float a = ex2((float)(dir ? (CHK - ii) : (ii + 1)) * l2);
              bf16_t* yo = yp + ((size_t)dir * MTOK + m0 + ii) * 1024 + 256 * h + 64 * slab + 8 * g4;
#pragma unroll
              for (int jp = 0; jp < 2; ++jp) { u32x4 o; o.x = pk2(y[2 * jp][0] * a, y[2 * jp][1] * a); o.y = pk2(y[2 * jp][2] * a, y[2 * jp][3] * a);
                  o.z = pk2(y[2 * jp + 1][0] * a, y[2 * jp + 1][1] * a); o.w = pk2(y[2 * jp + 1][2] * a, y[2 * jp + 1][3] * a); *(u32x4*)(yo + 32 * jp) = o; } }
            if (step < NCHK - 1) {
#pragma unroll
                for (int dd = 0; dd < 2; ++dd)
#pragma unroll
                    for (int et = 0; et < 4; ++et) S[dd][et] *= cdec;
                bf16x8 kfb[2][2], vfb[2][4];
#define RC_FRAGS(BUF, SS) do { _Pragma("unroll") for (int dd = 0; dd < 2; ++dd) { LAS unsigned char* a0 = KT + (32 * (SS) + 8 * g4 + q) * RS + (32 * w + 16 * dd + 4 * p) * 2; kfb[BUF][dd] = tr_pair(a0, a0 + 4 * RS); } \
                    _Pragma("unroll") for (int et = 0; et < 4; ++et) { LAS unsigned char* b0 = VT + (32 * (SS) + 8 * g4 + q) * RSV + (16 * et + 4 * p) * 2; vfb[BUF][et] = tr_pair(b0, b0 + 4 * RSV); } } while (0)
                RC_FRAGS(0, 0);
#pragma unroll
                for (int s = 0; s < 4; ++s) {
                    if (s < 3) RC_FRAGS((s + 1) & 1, s + 1);
#pragma unroll
                    for (int dd = 0; dd < 2; ++dd)
#pragma unroll
                        for (int et = 0; et < 4; ++et) S[dd][et] = __builtin_amdgcn_mfma_f32_16x16x32_bf16(kfb[s & 1][dd], vfb[s & 1][et], S[dd][et], 0, 0, 0);
                    RC_LOAD_Q(2 * s); if (s == 0) RC_LOAD_V();
                    __builtin_amdgcn_sched_barrier(0);
                }
#undef RC_FRAGS
            }
            __syncthreads();
            if (step < NCHK - 1) {
#pragma unroll
                for (int dd = 0; dd < 2; ++dd)
#pragma unroll
                    for (int et = 0; et < 4; ++et) { u32x2 o; o.x = pk2(S[dd][et][0], S[dd][et][1]); o.y = pk2(S[dd][et][2], S[dd][et][3]);
                        *(LAS u32x2*)(ST + (16 * et + fr) * RS + (32 * w + 16 * dd + 4 * g4) * 2) = o; }
            }
        }
#undef RC_PTRS
#undef RC_LOAD_K
#undef RC_LOAD_Q
#undef RC_LOAD_V
    }
}

__device__ __forceinline__ void ret_out_phase(const Ctx& F, const bf16_t* proj, const bf16_t* yp, bf16_t* cat, const float* dec_f, const float* dec_b) {
    LAS unsigned char* KT = F.lds; LAS unsigned char* VT = F.lds + 128 * RS;
    const int tid_ = F.tid, w = F.wave;
    for (int u = F.vcu; u < BATCH * NHEAD * NCHK; u += F.G) {
        const int bh = u >> 4, b = bh >> 2, h = bh & 3, n = u & 15;
        const size_t m0 = (size_t)b * SEQ + (size_t)n * CHK;
        const float lf2 = -__expf(dec_f[h]) * 1.44269504088896341f, lb2 = -__expf(dec_b[h]) * 1.44269504088896341f;
        int tid = tid_; asm volatile("" : "+v"(tid));
        const int lane = tid & 63, fr = lane & 15, g4 = lane >> 4, q = fr >> 2, p = fr & 3;
        const size_t m = m0 + 16 * w + fr;
        bf16x8 qf[8];
        { u32x4 kreg[8], vreg[8];
          const int row = tid >> 5, c16 = tid & 31;
          const bf16_t* kp = proj + (m0 + row) * INW + 2048 + 256 * h + c16 * 8; const bf16_t* vp = kp + 1024;
#pragma unroll
          for (int i = 0; i < 8; ++i) kreg[i] = *(const u32x4*)(kp + (size_t)(16 * i) * INW);
#pragma unroll
          for (int i = 0; i < 8; ++i) vreg[i] = *(const u32x4*)(vp + (size_t)(16 * i) * INW);
          const bf16_t* qp = proj + m * INW + 1024 + 256 * h + 8 * g4;
#pragma unroll
          for (int s = 0; s < 8; ++s) qf[s] = *(const bf16x8*)(qp + 32 * s);
          __syncthreads();
#pragma unroll
          for (int i = 0; i < 8; ++i) *(LAS u32x4*)(KT + (row + 16 * i) * RS + c16 * 16) = kreg[i];
#pragma unroll
          for (int i = 0; i < 8; ++i) *(LAS u32x4*)(VT + (row + 16 * i) * RS + c16 * 16) = vreg[i]; }
        __syncthreads();
        u32x4 yfq[8], ybq[8], gq[8];
        { const bf16_t* yf = yp + m * 1024 + 256 * h + 8 * g4; const bf16_t* yb = yp + ((size_t)MTOK + m) * 1024 + 256 * h + 8 * g4; const bf16_t* gp = proj + m * INW + 4096 + 256 * h + 8 * g4;
#pragma unroll
          for (int j = 0; j < 8; ++j) { yfq[j] = *(const u32x4*)(yf + 32 * j); ybq[j] = *(const u32x4*)(yb + 32 * j); gq[j] = *(const u32x4*)(gp + 32 * j); } }
        bf16x8 pb[4];
        {
            f32x4 pt[8];
            bf16x8 kfb[2][8];
#pragma unroll
            for (int s = 0; s < 8; ++s) kfb[0][s] = *(const LAS bf16x8*)(KT + (fr) * RS + (32 * s + 8 * g4) * 2);
#pragma unroll
            for (int jt = 0; jt < 8; ++jt) { pt[jt] = (f32x4){0.f, 0.f, 0.f, 0.f};
                if (jt < 7) {
#pragma unroll
                    for (int s = 0; s < 8; ++s) kfb[(jt + 1) & 1][s] = *(const LAS bf16x8*)(KT + (16 * (jt + 1) + fr) * RS + (32 * s + 8 * g4) * 2); }
#pragma unroll
                for (int s = 0; s < 8; ++s) pt[jt] = __builtin_amdgcn_mfma_f32_16x16x32_bf16(kfb[jt & 1][s], qf[s], pt[jt], 0, 0, 0);
                __builtin_amdgcn_sched_barrier(0); }
            const int il = 16 * w + fr;
#pragma unroll
            for (int jt = 0; jt < 8; ++jt)
#pragma unroll
                for (int r = 0; r < 4; ++r) { const int df = il - (16 * jt + 4 * g4 + r);
                    const float dcy = df >= 0 ? ex2((float)df * lf2) : ex2((float)(-df) * lb2);
                    pt[jt][r] *= dcy; }
#pragma unroll
            for (int s = 0; s < 4; ++s) pb[s] = pack8(pt[2 * s], pt[2 * s + 1]);
        }
        f32x4 ot[16];
#pragma unroll
        for (int et = 0; et < 16; ++et) ot[et] = (f32x4){0.f, 0.f, 0.f, 0.f};
        {
            bf16x8 vfb[2][8];
#define RO_FRAGS(BUF, B8) do { _Pragma("unroll") for (int e8 = 0; e8 < 8; ++e8) { LAS unsigned char* a0 = VT + (32 * ((B8) >> 1) + 4 * g4 + q) * RS + (16 * (8 * ((B8) & 1) + e8) + 4 * p) * 2; vfb[BUF][e8] = tr_pair(a0, a0 + 16 * RS); } } while (0)
            RO_FRAGS(0, 0);
#pragma unroll
            for (int b8 = 0; b8 < 8; ++b8) {
                if (b8 < 7) RO_FRAGS((b8 + 1) & 1, b8 + 1);
#pragma unroll
                for (int e8 = 0; e8 < 8; ++e8) ot[8 * (b8 & 1) + e8] = __builtin_amdgcn_mfma_f32_16x16x32_bf16(vfb[b8 & 1][e8], pb[b8 >> 1], ot[8 * (b8 & 1) + e8], 0, 0, 0);
                __builtin_amdgcn_sched_barrier(0);
            }
#undef RO_FRAGS
        }
        float ss = 0.f;
#pragma unroll
        for (int j = 0; j < 8; ++j) {
            ot[2 * j][0] += bflo(yfq[j].x) + bflo(ybq[j].x); ot[2 * j][1] += bfhi(yfq[j].x) + bfhi(ybq[j].x); ot[2 * j][2] += bflo(yfq[j].y) + bflo(ybq[j].y); ot[2 * j][3] += bfhi(yfq[j].y) + bfhi(ybq[j].y);
            ot[2 * j + 1][0] += bflo(yfq[j].z) + bflo(ybq[j].z); ot[2 * j + 1][1] += bfhi(yfq[j].z) + bfhi(ybq[j].z); ot[2 * j + 1][2] += bflo(yfq[j].w) + bflo(ybq[j].w); ot[2 * j + 1][3] += bfhi(yfq[j].w) + bfhi(ybq[j].w);
#pragma unroll
            for (int t = 0; t < 2; ++t) ss += (ot[2 * j + t][0] * ot[2 * j + t][0] + ot[2 * j + t][1] * ot[2 * j + t][1]) + (ot[2 * j + t][2] * ot[2 * j + t][2] + ot[2 * j + t][3] * ot[2 * j + t][3]); }
        ss += __shfl_xor(ss, 16); ss += __shfl_xor(ss, 32);
        const float rstd = 1.0f / sqrtf(ss * (1.0f / DH) + EPS);
        bf16_t* op = cat + m * DM + 1024 + 256 * h + 8 * g4;
#pragma unroll
        for (int j = 0; j < 8; ++j) {
            u32x4 o;
            o.x = pk2(pg8::fast_silu(bflo(gq[j].x)) * ot[2 * j][0] * rstd, pg8::fast_silu(bfhi(gq[j].x)) * ot[2 * j][1] * rstd);
            o.y = pk2(pg8::fast_silu(bflo(gq[j].y)) * ot[2 * j][2] * rstd, pg8::fast_silu(bfhi(gq[j].y)) * ot[2 * j][3] * rstd);
            o.z = pk2(pg8::fast_silu(bflo(gq[j].z)) * ot[2 * j + 1][0] * rstd, pg8::fast_silu(bfhi(gq[j].z)) * ot[2 * j + 1][1] * rstd);
            o.w = pk2(pg8::fast_silu(bflo(gq[j].w)) * ot[2 * j + 1][2] * rstd, pg8::fast_silu(bfhi(gq[j].w)) * ot[2 * j + 1][3] * rstd);
            *(u32x4*)(op + 32 * j) = o; }
    }
}

constexpr int NPHASE = 10;
struct Args { const float* in[16]; float* out; unsigned char* ws; int ph_lo, ph_hi; };
__global__ void __launch_bounds__(512, 2) fwd_kernel(Args args) {
    extern __shared__ __attribute__((aligned(16))) unsigned char lds_raw[];
    Ctx F;
    F.lds = (LAS unsigned char*)lds_raw;
    F.tid = threadIdx.x; F.lane = F.tid & 63; F.wave = __builtin_amdgcn_readfirstlane(F.tid >> 6);
    F.G = gridDim.x; { const int bx = blockIdx.x; F.vcu = (F.G % 8 == 0) ? (bx % 8) * (F.G / 8) + bx / 8 : bx; }
    unsigned char* ws = args.ws;
    gu32* ctl = (gu32*)(ws + WS_CTL);
    volatile LAS unsigned* MISC = (volatile LAS unsigned*)(F.lds + LDSCTL_OFF);
    for (int u = F.tid; u < (LDS_BYTES - LDSCTL_OFF) / 4; u += 512) ((LAS unsigned*)(F.lds + LDSCTL_OFF))[u] = 0u;
    __syncthreads();
    const int lo = args.ph_lo, hi = args.ph_hi;
    const bool multi = (hi - lo) > 1;
    XcdBarrier bar; bar.bar = (unsigned*)(ctl + CW_BAR); bar.x = 0; bar.st = nullptr;
    if (multi) bar = xcd_barrier_post((unsigned*)(ctl + CW_BAR), MISC + 8);
#ifndef PHASE_MASK
#define PHASE_MASK 0x3ff
#endif
#define IN(k) (((PHASE_MASK >> (k)) & 1) && lo <= (k) && (k) < hi)
#define SEAM(k) do { if (IN(k) && IN((k) + 1)) xcd_barrier(bar); { int t_ = threadIdx.x; asm volatile("" : "+v"(t_)); F.tid = t_; F.lane = t_ & 63; F.wave = __builtin_amdgcn_readfirstlane(t_ >> 6); } } while (0)
    const float* x = args.in[0]; const float* c = args.in[1]; const float* w_ada = args.in[2]; const float* b_ada = args.in[3]; const float* norm1_g = args.in[4];
    const float* w_in = args.in[5]; const float* pool_w = args.in[6]; const float* pool_scale = args.in[7]; const float* dec_f = args.in[8]; const float* dec_b = args.in[9];
    const float* w_out = args.in[10]; const float* norm2_g = args.in[11]; const float* w_gate = args.in[12]; const float* w_up = args.in[13]; const float* w_down = args.in[14]; const float* final_g = args.in[15];
    float* out = args.out;
    bf16_t* WinT = (bf16_t*)(ws + WS_WIN); bf16_t* WoT = (bf16_t*)(ws + WS_WO); bf16_t* WguT = (bf16_t*)(ws + WS_WGU); bf16_t* WdT = (bf16_t*)(ws + WS_WD);
    float* modp = (float*)(ws + WS_MODP); float* mod = (float*)(ws + WS_MOD); float* cosT = (float*)(ws + WS_ROPE); float* sinT = cosT + SEQ * 128;
    bf16_t* H = (bf16_t*)(ws + WS_H); bf16_t* CAT = (bf16_t*)(ws + WS_CAT); bf16_t* PROJ = (bf16_t*)(ws + WS_PROJ); bf16_t* ACT = (bf16_t*)(ws + WS_ACT);
    bf16_t* X1 = (bf16_t*)out;
    bf16_t* X2 = (bf16_t*)(ws + WS_H);

#ifndef REPEAT_MASK
#define REPEAT_MASK 0
#endif
#define REP(k) for (int rep_ = 0; rep_ < 1 + ((REPEAT_MASK >> (k)) & 1); ++rep_)
    if (IN(0)) REP(0) { P0Args A{c, w_ada, w_in, pool_w, pool_scale, w_out, w_gate, w_up, w_down, WinT, WoT, WguT, WdT, modp, cosT, sinT}; p0_prologue(F, A); __syncthreads(); }
    SEAM(0);
    if (IN(1)) REP(1) { norm_mod_phase<0>(F, x, H, norm1_g, modp, b_ada, mod, 0, 1); }
    SEAM(1);
    if (IN(2)) REP(2) { pg8::Gemm g{H, WinT, MTOK, INW, DM}; pg8::StaticOrder S; S.init(MTOK, INW, F.G, (int)blockIdx.x); pg8::EpiProj E{PROJ, cosT, sinT};
        pg8::gemm_phase<pg8::EpiProj, pg8::StaticOrder, true, true>(F.lds, g, S, E); }
    SEAM(2);
    if (IN(3)) REP(3) { pool_phase(F, PROJ, CAT); ret_chain_phase(F, PROJ, (bf16_t*)out, dec_f, dec_b); }
    SEAM(3);
    if (IN(4)) REP(4) { ret_out_phase(F, PROJ, (const bf16_t*)out, CAT, dec_f, dec_b); }
    SEAM(4);
    if (IN(5)) REP(5) { pg8::Gemm g{CAT, WoT, MTOK, DM, DM}; pg8::StaticOrder S; S.init(MTOK, DM, F.G, (int)blockIdx.x); pg8::EpiRes<false> E{x, X1, mod + 2 * DM};
        pg8::gemm_phase<pg8::EpiRes<false>, pg8::StaticOrder, true, true>(F.lds, g, S, E); }
    SEAM(5);
    if (IN(6)) REP(6) { norm_mod_bf16_phase(F, X1, H, norm2_g, mod, 3, 4); }
    SEAM(6);
    if (IN(7)) REP(7) { pg8::Gemm g{H, WguT, MTOK, 2 * FF, DM}; pg8::StaticOrder S; S.init(MTOK, 2 * FF, F.G, (int)blockIdx.x); pg8::EpiSwiGLU E{ACT};
        pg8::gemm_phase<pg8::EpiSwiGLU, pg8::StaticOrder, true, true>(F.lds, g, S, E); }
    SEAM(7);
    if (IN(8)) REP(8) { pg8::Gemm g{ACT, WdT, MTOK, DM, FF}; pg8::StaticOrder S; S.init(MTOK, DM, F.G, (int)blockIdx.x); pg8::EpiRes<true> E{X1, X2, mod + 5 * DM};
        pg8::gemm_phase<pg8::EpiRes<true>, pg8::StaticOrder, true, true>(F.lds, g, S, E); }
    SEAM(8);
    if (IN(9)) REP(9) { final_norm_phase(F, X2, out, final_g); }
#undef IN
#undef SEAM
}

#ifndef MK_PER_PHASE
#define MK_PER_PHASE 0
#endif
extern "C" void kernel_launch(void* const* d_in, const int* in_sizes, int n_in, void* d_out, int out_size, void* d_ws, size_t ws_size, hipStream_t stream) {
    static int grid = 0;
    if (grid == 0) {
        if (n_in != 16 || in_sizes[0] != MTOK * DM || out_size != MTOK * DM || ws_size < WS_END) { fprintf(stderr, "kernel_launch: unexpected shapes (n_in %d, in0 %d, out %d, ws %zu)\n", n_in, n_in > 0 ? in_sizes[0] : -1, out_size, ws_size); grid = -1; return; }
        int dev = 0, cus = 0, per_cu = 0;
        if (hipGetDevice(&dev) != hipSuccess || hipDeviceGetAttribute(&cus, hipDeviceAttributeMultiprocessorCount, dev) != hipSuccess) { grid = -1; return; }
        if (hipFuncSetAttribute((const void*)fwd_kernel, hipFuncAttributeMaxDynamicSharedMemorySize, LDS_BYTES) != hipSuccess) { fprintf(stderr, "kernel_launch: hipFuncSetAttribute failed\n"); grid = -1; return; }
        if (hipOccupancyMaxActiveBlocksPerMultiprocessor(&per_cu, (const void*)fwd_kernel, 512, LDS_BYTES) != hipSuccess || per_cu < 1) { fprintf(stderr, "kernel_launch: occupancy query says %d blocks per CU\n", per_cu); }
        (void)hipGetLastError();
        grid = cus;
    }
    if (grid < 0) return;
    if (hipMemsetAsync((char*)d_ws + WS_CTL, 0, CTL_ZERO_BYTES, stream) != hipSuccess) return;
    Args a{};
    for (int i = 0; i < 16; ++i) a.in[i] = (const float*)d_in[i];
    a.out = (float*)d_out; a.ws = (unsigned char*)d_ws;
#if MK_PER_PHASE
    for (int ph = 0; ph < NPHASE; ++ph) { a.ph_lo = ph; a.ph_hi = ph + 1; hipLaunchKernelGGL(fwd_kernel, dim3(grid), dim3(512), LDS_BYTES, stream, a); }
#else
    a.ph_lo = 0; a.ph_hi = NPHASE;
    hipLaunchKernelGGL(fwd_kernel, dim3(grid), dim3(512), LDS_BYTES, stream, a);
#endif
}
```

```cpp
#include <hip/hip_runtime.h>
#include <cstdio>
#include <cstdint>

#define LAS __attribute__((address_space(3)))
#define GAS __attribute__((address_space(1)))
typedef unsigned short bf16_t;
typedef short bf16x8 __attribute__((ext_vector_type(8)));
typedef short s16x4 __attribute__((ext_vector_type(4)));
typedef float f32x4 __attribute__((ext_vector_type(4)));
typedef float f32x2 __attribute__((ext_vector_type(2)));
typedef unsigned u32x4 __attribute__((ext_vector_type(4)));
typedef unsigned u32x2 __attribute__((ext_vector_type(2)));
typedef GAS unsigned gu32;

constexpr int BATCH = 8, SEQ = 2048, DM = 2048, MTOK = BATCH * SEQ;
constexpr int POOLW = 1024, NHEAD = 4, DH = 256, CHK = 128, NCHK = SEQ / CHK;
constexpr int FF = 5632, INW = 5120, NMODW = 6 * DM;
constexpr float EPS = 1e-6f;
constexpr int ADA_KC = 16;

constexpr size_t MiB = 1u << 20;
constexpr size_t WS_CTL = 0, CTL_ZERO_BYTES = 65536;
constexpr size_t WS_WIN = 1 * MiB, WS_WO = 21 * MiB, WS_WGU = 29 * MiB, WS_WD = 73 * MiB;
constexpr size_t WS_MODP = 95 * MiB, WS_MOD = 102 * MiB, WS_ROPE = 103 * MiB;
constexpr size_t WS_H = 170 * MiB, WS_CAT = 106 * MiB, WS_PROJ = 234 * MiB, WS_ACT = 234 * MiB, WS_END = 410 * MiB;
constexpr int CW_TMO = 0, CW_BAR = 4096;

constexpr int RING_BYTES = 143360, LDSCTL_OFF = RING_BYTES, LDS_BYTES = 147456;

namespace pg8 {
constexpr int BM = 256, BK = 64, HALF = 128, HTB = HALF * BK * 2, STAGE_BYTES = 8 * HTB, NXCD = 8, WGM = 4;
__host__ __device__ __forceinline__ int lds_byte(int r, int c) { const int st = (r >> 4) * 2 + (c >> 5), rr = r & 15, cc = c & 31, ob = rr * 64 + cc * 2; return st * 1024 + (ob ^ (((ob >> 9) & 1) << 5)); }
__host__ __device__ __forceinline__ void stage_rc(int b, int& R, int& C) { const int st = b / 1024, sb = b % 1024, swz = sb ^ (((sb >> 9) & 1) << 5); R = (st >> 1) * 16 + swz / 64; C = (st & 1) * 32 + (swz % 64) / 2; }
__host__ __device__ __forceinline__ int perm32(int rho) { const int n = rho >> 4, i = rho & 15; return 8 * (i >> 2) + 4 * n + (i & 3); }

struct Unit { int pm, pn; };
struct Gemm { const bf16_t* A; const bf16_t* Bt; int M, N, K; };

struct StaticOrder {
    int nM, nN, nwg, G, c;
    __host__ __device__ void init(int M, int N, int G_, int c_) { nM = M / BM; nN = N / BM; nwg = nM * nN; G = G_; c = c_; }
    __host__ __device__ bool next(int i, Unit& u) const {
        const long L = (long)i * G + c; if (L >= nwg) return false;
        int wgid = (int)L; { const int q = nwg / NXCD, r = nwg % NXCD, xcd = wgid % NXCD, off = wgid / NXCD; wgid = (xcd < r ? xcd * (q + 1) : r * (q + 1) + (xcd - r) * q) + off; }
        const int nig = WGM * nN, gid = wgid / nig, fm = gid * WGM, gsz = (nM - fm) < WGM ? (nM - fm) : WGM;
        u.pm = fm + ((wgid % nig) % gsz); u.pn = (wgid % nig) / gsz; return true;
    }
    __device__ __forceinline__ void a_ready(const Unit&) const {}
    __device__ __forceinline__ void done(const Unit&) const {}
};

__device__ __forceinline__ unsigned cvt_pk_bf16(float lo, float hi) { unsigned r; asm volatile("v_cvt_pk_bf16_f32 %0, %1, %2" : "=v"(r) : "v"(lo), "v"(hi)); return r; }
__device__ __forceinline__ float bflo_(unsigned w) { return __builtin_bit_cast(float, w << 16); }
__device__ __forceinline__ float bfhi_(unsigned w) { return __builtin_bit_cast(float, w & 0xffff0000u); }
__device__ __forceinline__ float fast_silu(float v) { return v * __builtin_amdgcn_rcpf(1.0f + __expf(-v)); }

struct EpiProj {
    static constexpr bool PERM = true, AFTER_DRAIN = false;
    bf16_t* O; const float* cosT; const float* sinT;
    __device__ __forceinline__ void operator()(f32x4 (&acc)[2][2][4][2], const Unit& u, int wr, int wc, int fr, int fq) const {
        const int row0 = u.pm * BM + wr * 64 + fr, col0 = u.pn * BM + wc * 32 + 8 * fq;
        const bool rot = (u.pn >= 4) && (u.pn < 12); const float qs = (u.pn < 8) ? 0.0625f : 1.0f;
        const int jj0 = wc * 32 + 8 * fq;
#pragma unroll
        for (int ai = 0; ai < 2; ++ai)
#pragma unroll
            for (int m = 0; m < 4; ++m) {
                const int row = row0 + ai * HALF + m * 16; bf16_t* rowp = O + (size_t)row * INW + col0;
                f32x4 a0 = acc[ai][0][m][0], a1 = acc[ai][0][m][1], b0 = acc[ai][1][m][0], b1 = acc[ai][1][m][1];
                if (rot) {
                    const int pos = row & (SEQ - 1);
                    const f32x4 c0 = *(const f32x4*)(cosT + pos * 128 + jj0), c1 = *(const f32x4*)(cosT + pos * 128 + jj0 + 4);
                    const f32x4 s0 = *(const f32x4*)(sinT + pos * 128 + jj0), s1 = *(const f32x4*)(sinT + pos * 128 + jj0 + 4);
                    const f32x4 o10 = (a0 * c0 - b0 * s0) * qs, o11 = (a1 * c1 - b1 * s1) * qs;
                    const f32x4 o20 = (a0 * s0 + b0 * c0) * qs, o21 = (a1 * s1 + b1 * c1) * qs;
                    a0 = o10; a1 = o11; b0 = o20; b1 = o21;
                }
                u32x4 w0, w1;
                w0.x = cvt_pk_bf16(a0[0], a0[1]); w0.y = cvt_pk_bf16(a0[2], a0[3]); w0.z = cvt_pk_bf16(a1[0], a1[1]); w0.w = cvt_pk_bf16(a1[2], a1[3]);
                w1.x = cvt_pk_bf16(b0[0], b0[1]); w1.y = cvt_pk_bf16(b0[2], b0[3]); w1.z = cvt_pk_bf16(b1[0], b1[1]); w1.w = cvt_pk_bf16(b1[2], b1[3]);
                *(u32x4*)(rowp) = w0; *(u32x4*)(rowp + HALF) = w1;
            }
    }
};
template <bool BASE_BF16> struct EpiRes {
    static constexpr bool PERM = true, AFTER_DRAIN = false;
    const void* base; bf16_t* out; const float* gv;
    __device__ __forceinline__ void operator()(f32x4 (&acc)[2][2][4][2], const Unit& u, int wr, int wc, int fr, int fq) const {
        const int col0 = u.pn * BM + wc * 32 + 8 * fq; const int b = u.pm >> 3;
        f32x4 g[2][2];
#pragma unroll
        for (int bj = 0; bj < 2; ++bj)
#pragma unroll
            for (int n = 0; n < 2; ++n) g[bj][n] = *(const f32x4*)(gv + (size_t)b * NMODW + col0 + bj * HALF + n * 4);
#pragma unroll
        for (int ai = 0; ai < 2; ++ai) {
            if constexpr (BASE_BF16) {
                u32x4 pre[4][2];
#pragma unroll
                for (int m = 0; m < 4; ++m) { const size_t off = (size_t)(u.pm * BM + ai * HALF + wr * 64 + m * 16 + fr) * DM + col0;
#pragma unroll
                    for (int bj = 0; bj < 2; ++bj) pre[m][bj] = *(const u32x4*)((const bf16_t*)base + off + bj * HALF); }
#pragma unroll
                for (int m = 0; m < 4; ++m) { const size_t off = (size_t)(u.pm * BM + ai * HALF + wr * 64 + m * 16 + fr) * DM + col0;
#pragma unroll
                    for (int bj = 0; bj < 2; ++bj) { const u32x4 p = pre[m][bj]; const f32x4 a0 = acc[ai][bj][m][0] * g[bj][0], a1 = acc[ai][bj][m][1] * g[bj][1];
                        u32x4 w; w.x = cvt_pk_bf16(bflo_(p.x) + a0[0], bfhi_(p.x) + a0[1]); w.y = cvt_pk_bf16(bflo_(p.y) + a0[2], bfhi_(p.y) + a0[3]);
                        w.z = cvt_pk_bf16(bflo_(p.z) + a1[0], bfhi_(p.z) + a1[1]); w.w = cvt_pk_bf16(bflo_(p.w) + a1[2], bfhi_(p.w) + a1[3]);
                        *(u32x4*)(out + off + bj * HALF) = w; } }
            } else {
                f32x4 pre[4][2][2];
#pragma unroll
                for (int m = 0; m < 4; ++m) { const size_t off = (size_t)(u.pm * BM + ai * HALF + wr * 64 + m * 16 + fr) * DM + col0;
#pragma unroll
                    for (int bj = 0; bj < 2; ++bj)
#pragma unroll
                        for (int n = 0; n < 2; ++n) pre[m][bj][n] = *(const f32x4*)((const float*)base + off + bj * HALF + n * 4); }
#pragma unroll
                for (int m = 0; m < 4; ++m) { const size_t off = (size_t)(u.pm * BM + ai * HALF + wr * 64 + m * 16 + fr) * DM + col0;
#pragma unroll
                    for (int bj = 0; bj < 2; ++bj) { const f32x4 v0 = pre[m][bj][0] + acc[ai][bj][m][0] * g[bj][0], v1 = pre[m][bj][1] + acc[ai][bj][m][1] * g[bj][1];
                        u32x4 w; w.x = cvt_pk_bf16(v0[0], v0[1]); w.y = cvt_pk_bf16(v0[2], v0[3]); w.z = cvt_pk_bf16(v1[0], v1[1]); w.w = cvt_pk_bf16(v1[2], v1[3]);
                        *(u32x4*)(out + off + bj * HALF) = w; } }
            }
            asm volatile("" ::: "memory");
        }
    }
};
struct EpiSwiGLU {
    static constexpr bool PERM = true, AFTER_DRAIN = false;
    bf16_t* O;
    __device__ __forceinline__ void operator()(f32x4 (&acc)[2][2][4][2], const Unit& u, int wr, int wc, int fr, int fq) const {
        const int row0 = u.pm * BM + wr * 64 + fr, col0 = u.pn * HALF + wc * 32 + 8 * fq;
#pragma unroll
        for (int ai = 0; ai < 2; ++ai)
#pragma unroll
            for (int m = 0; m < 4; ++m) {
                bf16_t* rowp = O + (size_t)(row0 + ai * HALF + m * 16) * FF + col0;
                const f32x4 g0 = acc[ai][0][m][0], g1 = acc[ai][0][m][1], u0 = acc[ai][1][m][0], u1 = acc[ai][1][m][1];
                f32x4 o0, o1;
#pragma unroll
                for (int e = 0; e < 4; ++e) { o0[e] = fast_silu(g0[e]) * u0[e]; o1[e] = fast_silu(g1[e]) * u1[e]; }
                u32x4 w; w.x = cvt_pk_bf16(o0[0], o0[1]); w.y = cvt_pk_bf16(o0[2], o0[3]); w.z = cvt_pk_bf16(o1[0], o1[1]); w.w = cvt_pk_bf16(o1[2], o1[3]);
                *(u32x4*)rowp = w;
            }
    }
};

template <class Epi, class Sched, bool ALIGN_EPI = false, bool SP2 = false>
__device__ __forceinline__ void gemm_phase(LAS unsigned char* lds, const Gemm g, const Sched& S, const Epi& E) {
    int tid = threadIdx.x; asm volatile("" : "+v"(tid));
    const int wid = __builtin_amdgcn_readfirstlane(tid >> 6), lane = tid & 63, wr = wid >> 2, wc = wid & 3, fr = lane & 15, fq = lane >> 4;
    const int K = g.K, nt = K / BK;
    unsigned voffA[2], voffB[2];
#pragma unroll
    for (int i = 0; i < 2; ++i) { int R, C; stage_rc(tid * 16 + i * 8192, R, C); const int Rb = Epi::PERM ? ((R & ~31) + perm32(R & 31)) : R;
        voffA[i] = (unsigned)(R * K + C) * 2u; voffB[i] = (unsigned)(Rb * K + C) * 2u; }
    const size_t kstep = (size_t)(BK * 2);
    const size_t hstep = (size_t)HALF * K * 2;
    const size_t tstep = 2 * hstep;
    const unsigned ldsw = (unsigned)wid * 1024u;
    const int aoff = lds_byte(wr * 64 + fr, fq * 8), boff = lds_byte(wc * 32 + fr, fq * 8);
#define PG8_SA(b, h) (((b) * 2 + (h)) * HTB)
#define PG8_SB(b, h) ((4 + (b) * 2 + (h)) * HTB)
#define PG8_STAGE(bufoff, gbase, voff) do { _Pragma("unroll") for (int _i = 0; _i < 2; ++_i) \
        __builtin_amdgcn_global_load_lds((const unsigned*)((const char*)(gbase) + (voff)[_i]), (LAS unsigned*)(lds + (bufoff) + ldsw + _i * 8192), 16, 0, 0); } while (0)
#define PG8_LDA(dst, b, h) do { _Pragma("unroll") for (int m = 0; m < 4; ++m) _Pragma("unroll") for (int k = 0; k < 2; ++k) dst[m][k] = *(const LAS bf16x8*)(lds + PG8_SA(b, h) + aoff + m * 2048 + k * 1024); } while (0)
#define PG8_LDB(dst, b, h) do { _Pragma("unroll") for (int n = 0; n < 2; ++n) _Pragma("unroll") for (int k = 0; k < 2; ++k) dst[n][k] = *(const LAS bf16x8*)(lds + PG8_SB(b, h) + boff + n * 2048 + k * 1024); } while (0)
#define PG8_MMA(ai, bj, At, Bt) do { __builtin_amdgcn_s_setprio(1); _Pragma("unroll") for (int k = 0; k < 2; ++k) _Pragma("unroll") for (int m = 0; m < 4; ++m) _Pragma("unroll") for (int n = 0; n < 2; ++n) \
        acc[ai][bj][m][n] = __builtin_amdgcn_mfma_f32_16x16x32_bf16(Bt[n][k], At[m][k], acc[ai][bj][m][n], 0, 0, 0); __builtin_amdgcn_s_setprio(0); } while (0)
#define PG8_WAIT_V(n) asm volatile("s_waitcnt vmcnt(" #n ")" ::: "memory")
#define PG8_WAIT_L(n) asm volatile("s_waitcnt lgkmcnt(" #n ")" ::: "memory")
#define PG8_BAR __builtin_amdgcn_s_barrier()
#define PG8_SCHED __builtin_amdgcn_sched_barrier(0)
    Unit cur, nxt; int ui = 0;
    if (!S.next(0, cur)) return;
    f32x4 acc[2][2][4][2];
#pragma unroll
    for (int a = 0; a < 2; ++a)
#pragma unroll
        for (int b = 0; b < 2; ++b)
#pragma unroll
            for (int m = 0; m < 4; ++m)
#pragma unroll
                for (int n = 0; n < 2; ++n) acc[a][b][m][n] = (f32x4){0.f, 0.f, 0.f, 0.f};
    bf16x8 At[4][2], B0[2][2], B1[2][2];
    const char* cA = (const char*)g.A + (size_t)cur.pm * tstep; const char* cB = (const char*)g.Bt + (size_t)cur.pn * tstep;
    S.a_ready(cur);
    if constexpr (SP2) {
        PG8_STAGE(PG8_SB(0, 0), cB, voffB); PG8_STAGE(PG8_SB(0, 1), cB + hstep, voffB); PG8_STAGE(PG8_SA(0, 0), cA, voffA); PG8_STAGE(PG8_SA(0, 1), cA + hstep, voffA);
        if (wr == 1) PG8_BAR;
        PG8_WAIT_V(2); PG8_BAR;
        PG8_STAGE(PG8_SB(1, 0), cB + kstep, voffB); PG8_STAGE(PG8_SA(1, 0), cA + kstep, voffA); PG8_STAGE(PG8_SB(1, 1), cB + hstep + kstep, voffB);
        PG8_WAIT_V(6); PG8_BAR;
    } else {
        PG8_STAGE(PG8_SB(0, 0), cB, voffB); PG8_STAGE(PG8_SA(0, 0), cA, voffA); PG8_STAGE(PG8_SB(0, 1), cB + hstep, voffB); PG8_STAGE(PG8_SA(0, 1), cA + hstep, voffA);
        if (wr == 1) PG8_BAR;
        PG8_WAIT_V(4); PG8_BAR;
        PG8_STAGE(PG8_SB(1, 0), cB + kstep, voffB); PG8_STAGE(PG8_SA(1, 0), cA + kstep, voffA); PG8_STAGE(PG8_SB(1, 1), cB + hstep + kstep, voffB);
        PG8_WAIT_V(6); PG8_BAR;
    }
    for (;;) {
        const bool has_next = S.next(ui + 1, nxt);
        const char* nA = has_next ? (const char*)g.A + (size_t)nxt.pm * tstep : cA; const char* nB = has_next ? (const char*)g.Bt + (size_t)nxt.pn * tstep : cB;
        for (int t = 0; t < nt; t += 2) {
            const bool last = (t == nt - 2);
            const char* a1 = cA + (size_t)(t + 1) * kstep;
            const char* a2 = last ? nA : cA + (size_t)(t + 2) * kstep; const char* b2 = last ? nB : cB + (size_t)(t + 2) * kstep;
            const char* a3 = a2 + kstep; const char* b3 = b2 + kstep;
            if (last && has_next) S.a_ready(nxt);
            if constexpr (SP2) {
            PG8_LDB(B0, 0, 0); PG8_LDB(B1, 0, 1); PG8_SCHED; PG8_LDA(At, 0, 0); PG8_STAGE(PG8_SA(1, 1), a1 + hstep, voffA);
            PG8_WAIT_V(8); PG8_WAIT_L(0); PG8_BAR; PG8_MMA(0, 0, At, B0); PG8_MMA(0, 1, At, B1); PG8_BAR; PG8_SCHED;
            PG8_LDA(At, 0, 1); PG8_STAGE(PG8_SB(0, 0), b2, voffB); PG8_STAGE(PG8_SB(0, 1), b2 + hstep, voffB); PG8_STAGE(PG8_SA(0, 0), a2, voffA);
            PG8_WAIT_V(8); PG8_WAIT_L(0); PG8_BAR; PG8_MMA(1, 0, At, B0); PG8_MMA(1, 1, At, B1); PG8_BAR; PG8_SCHED;
            PG8_LDB(B0, 1, 0); PG8_LDB(B1, 1, 1); PG8_SCHED; PG8_LDA(At, 1, 0); PG8_STAGE(PG8_SA(0, 1), a2 + hstep, voffA);
            PG8_WAIT_V(8); PG8_WAIT_L(0); PG8_BAR; PG8_MMA(0, 0, At, B0); PG8_MMA(0, 1, At, B1); PG8_BAR; PG8_SCHED;
            PG8_LDA(At, 1, 1); PG8_STAGE(PG8_SB(1, 0), b3, voffB); PG8_STAGE(PG8_SB(1, 1), b3 + hstep, voffB); PG8_STAGE(PG8_SA(1, 0), a3, voffA);
            PG8_WAIT_V(8); PG8_WAIT_L(0); PG8_BAR; PG8_MMA(1, 0, At, B0); PG8_MMA(1, 1, At, B1); PG8_BAR; PG8_SCHED;
            } else {
            PG8_LDB(B0, 0, 0); PG8_SCHED; PG8_LDA(At, 0, 0); PG8_STAGE(PG8_SA(1, 1), a1 + hstep, voffA);
            PG8_WAIT_L(8); PG8_BAR; PG8_WAIT_L(0); PG8_MMA(0, 0, At, B0); PG8_BAR; PG8_SCHED;
            PG8_LDB(B1, 0, 1); PG8_STAGE(PG8_SB(0, 0), b2, voffB);
            PG8_BAR; PG8_WAIT_L(0); PG8_MMA(0, 1, At, B1); PG8_BAR;
            PG8_LDA(At, 0, 1); PG8_STAGE(PG8_SA(0, 0), a2, voffA);
            PG8_BAR; PG8_WAIT_L(0); PG8_MMA(1, 0, At, B0); PG8_BAR; PG8_SCHED;
            PG8_STAGE(PG8_SB(0, 1), b2 + hstep, voffB);
            PG8_WAIT_V(6); PG8_BAR; PG8_MMA(1, 1, At, B1); PG8_BAR;
            PG8_LDB(B0, 1, 0); PG8_SCHED; PG8_LDA(At, 1, 0); PG8_STAGE(PG8_SA(0, 1), a2 + hstep, voffA);
            PG8_WAIT_L(8); PG8_BAR; PG8_WAIT_L(0); PG8_MMA(0, 0, At, B0); PG8_BAR; PG8_SCHED;
            PG8_LDB(B1, 1, 1); PG8_STAGE(PG8_SB(1, 0), b3, voffB);
            PG8_BAR; PG8_WAIT_L(0); PG8_MMA(0, 1, At, B1); PG8_BAR;
            PG8_LDA(At, 1, 1); PG8_STAGE(PG8_SA(1, 0), a3, voffA);
            PG8_BAR; PG8_WAIT_L(0); PG8_MMA(1, 0, At, B0); PG8_BAR; PG8_SCHED;
            PG8_STAGE(PG8_SB(1, 1), b3 + hstep, voffB);
            PG8_WAIT_V(6); PG8_BAR; PG8_MMA(1, 1, At, B1); PG8_BAR;
            }
        }
        if constexpr (ALIGN_EPI) { if (wr == 0) PG8_BAR; }
        if constexpr (!Epi::AFTER_DRAIN) { E(acc, cur, wr, wc, fr, fq); S.done(cur); }
        if (!has_next) break;
#pragma unroll
        for (int a = 0; a < 2; ++a)
#pragma unroll
            for (int b = 0; b < 2; ++b)
#pragma unroll
                for (int m = 0; m < 4; ++m)
#pragma unroll
                    for (int n = 0; n < 2; ++n) acc[a][b][m][n] = (f32x4){0.f, 0.f, 0.f, 0.f};
        cur = nxt; cA = nA; cB = nB; ++ui;
        if constexpr (ALIGN_EPI) { if (wr == 1) PG8_BAR; }
    }
    PG8_WAIT_V(0);
    if constexpr (!ALIGN_EPI) { if (wr == 0) PG8_BAR; }
    PG8_BAR;
#undef PG8_SA
#undef PG8_SB
#undef PG8_STAGE
#undef PG8_LDA
#undef PG8_LDB
#undef PG8_MMA
#undef PG8_WAIT_V
#undef PG8_WAIT_L
#undef PG8_BAR
#undef PG8_SCHED
}
}

#define RLX_AGENT __ATOMIC_RELAXED, __HIP_MEMORY_SCOPE_AGENT
#define LDS_WAIT() asm volatile("s_waitcnt lgkmcnt(0)" ::: "memory")
__device__ __forceinline__ unsigned f2bf(float f) { unsigned u = __builtin_bit_cast(unsigned, f); return (u + 0x7fffu + ((u >> 16) & 1u)) >> 16; }
__device__ __forceinline__ unsigned pk2(float lo, float hi) { return f2bf(lo) | (f2bf(hi) << 16); }
__device__ __forceinline__ float bflo(unsigned w) { return __builtin_bit_cast(float, w << 16); }
__device__ __forceinline__ float bfhi(unsigned w) { return __builtin_bit_cast(float, w & 0xffff0000u); }
__device__ __forceinline__ float ex2(float x) { return __builtin_amdgcn_exp2f(x); }
__device__ __forceinline__ float wave_sum(float v) {
#pragma unroll
    for (int o = 1; o < 64; o <<= 1) v += __shfl_xor(v, o);
    return v;
}

#define XB_TMO      128
#define XB_XCNT(j)  (256  + 64 * (j))
#define XB_XSUB(j)  (1280 + 64 * (j))
#define XB_XGEN(j)  (2304 + 64 * (j))
#define XB_TOP      3328
#define XB_TOPGEN   3392
#define XCD_BAR_WORDS 3456
#define XB_SPIN_CAP (1u << 18)
__device__ __forceinline__ unsigned xb_ld(unsigned* p)              { return __hip_atomic_load(p, __ATOMIC_RELAXED, __HIP_MEMORY_SCOPE_AGENT); }
__device__ __forceinline__ unsigned xb_add(unsigned* p, unsigned v) { return __hip_atomic_fetch_add(p, v, __ATOMIC_RELAXED, __HIP_MEMORY_SCOPE_AGENT); }
__device__ __forceinline__ unsigned xb_xcc_id() { return (unsigned)__builtin_amdgcn_s_getreg((3 << 11) | 20) & 0xFu; }
#define XB_SPIN(cond, bar) do { unsigned _sp = 0; while (cond) { __builtin_amdgcn_s_sleep(1); \
    if ((++_sp & 255u) == 0u) { if (xb_ld(&(bar)[XB_TMO])) break; if (_sp > XB_SPIN_CAP) { atomicAdd(&(bar)[XB_TMO], 1u); break; } } } } while (0)
struct XcdBarrier { unsigned* bar; unsigned x; volatile LAS unsigned* st; };
__device__ __forceinline__ XcdBarrier xcd_barrier_post(unsigned* bar, volatile LAS unsigned* st) {
    XcdBarrier b; b.bar = bar; b.x = xb_xcc_id(); b.st = st;
    if (threadIdx.x == 0) (void)xb_add(&bar[XB_XCNT(b.x)], 1u);
    return b;
}
__device__ __forceinline__ void xcd_barrier_complete(unsigned* bar, unsigned x, unsigned& nloc, unsigned& nx) {
    const unsigned G = gridDim.x * gridDim.y * gridDim.z;
    unsigned sum, cnt, mine, sp = 0u;
    for (;;) {
        sum = 0u; cnt = 0u; mine = 0u;
#pragma unroll
        for (unsigned j = 0; j < 16; ++j) { const unsigned c = xb_ld(&bar[XB_XCNT(j)]); sum += c; cnt += (c > 0u) ? 1u : 0u; mine = (j == x) ? c : mine; }
        if (sum == G) break;
        __builtin_amdgcn_s_sleep(1);
        if ((++sp & 255u) == 0u) { if (xb_ld(&bar[XB_TMO])) break; if (sp > XB_SPIN_CAP) { atomicAdd(&bar[XB_TMO], 1u); break; } }
    }
    nloc = mine > 0u ? mine : 1u; nx = cnt > 0u ? cnt : 1u;
}
__device__ __forceinline__ void xcd_barrier(const XcdBarrier& b) {
    asm volatile("s_waitcnt vmcnt(0)" ::: "memory");
    __syncthreads();
    if (threadIdx.x == 0) {
        unsigned* bar = b.bar;
        __builtin_amdgcn_s_waitcnt(0);
        unsigned nloc = b.st[0], nx = b.st[1];
        if (nloc == 0u) { xcd_barrier_complete(bar, b.x, nloc, nx); b.st[0] = nloc; b.st[1] = nx; }
        const unsigned old = xb_add(&bar[XB_XSUB(b.x)], 1u);
        const unsigned gen = old / nloc;
        if (old + 1u == (gen + 1u) * nloc) {
            __builtin_amdgcn_fence(__ATOMIC_RELEASE, "agent");
            asm volatile("s_waitcnt vmcnt(0)" ::: "memory");
            const unsigned og = xb_add(&bar[XB_TOP], 1u);
            const unsigned tg = og / nx;
            if (og + 1u == (tg + 1u) * nx) xb_add(&bar[XB_TOPGEN], 1u);
            else XB_SPIN(xb_ld(&bar[XB_TOPGEN]) == tg, bar);
            __builtin_amdgcn_fence(__ATOMIC_ACQUIRE, "agent");
            xb_add(&bar[XB_XGEN(b.x)], 1u);
            asm volatile("s_waitcnt vmcnt(0)" ::: "memory");
        } else {
            XB_SPIN(xb_ld(&bar[XB_XGEN(b.x)]) == gen, bar);
            __builtin_amdgcn_fence(__ATOMIC_ACQUIRE, "agent");
            asm volatile("s_waitcnt vmcnt(0)" ::: "memory");
        }
    }
    __syncthreads();
}

struct Ctx { LAS unsigned char* lds; int tid, lane, wave, vcu, G; };

__host__ __device__ __forceinline__ int perm5(int n) { return 8 * ((n >> 2) & 3) + 4 * ((n >> 4) & 1) + (n & 3); }
template <bool PERMN, bool PERMK>
__device__ __forceinline__ void p0_transpose_item(const float* W, int ldw, bf16_t* WT, int kdst, int k0, int n_src0, int drow0, LAS float* scr, int lane) {
#pragma unroll 8
    for (int i = 0; i < 32; ++i) { const int kk = 2 * i + (lane >> 5); scr[kk * 33 + (lane & 31)] = W[(size_t)(k0 + kk) * ldw + n_src0 + (lane & 31)]; }
    LDS_WAIT(); asm volatile("" ::: "memory");
    const int c = lane & 7;
#pragma unroll
    for (int j = 0; j < 4; ++j) { const int n = (lane >> 3) + 8 * j;
        float v[8];
#pragma unroll
        for (int e = 0; e < 8; ++e) { const int kk = PERMK ? (32 * (c >> 2) + 16 * (e >> 2) + 4 * (c & 3) + (e & 3)) : (8 * c + e); v[e] = scr[kk * 33 + n]; }
        u32x4 o; o.x = pk2(v[0], v[1]); o.y = pk2(v[2], v[3]); o.z = pk2(v[4], v[5]); o.w = pk2(v[6], v[7]);
        *(GAS u32x4*)(WT + (size_t)(drow0 + (PERMN ? perm5(n) : n)) * kdst + k0 + 8 * c) = o; }
    LDS_WAIT(); asm volatile("" ::: "memory");
}

struct P0Args { const float *c, *w_ada, *w_in, *pool_w, *pool_scale, *w_out, *w_gate, *w_up, *w_down; bf16_t *WinT, *WoT, *WguT, *WdT; float *modp, *cosT, *sinT; };

__device__ __forceinline__ void p0_prologue(const Ctx& F, const P0Args& A) {
    const int tid = F.tid, lane = F.lane, w = F.wave;
    {
        LAS float* cact = (LAS float*)(F.lds);
        LAS float* red = (LAS float*)(F.lds + 12288);
        constexpr int NIT = 48 * ADA_KC;
        f32x4 wv[16], wvn[16];
        if (F.vcu < NIT) { const int cg = F.vcu % 48, kc = F.vcu / 48; const float* wp = A.w_ada + (size_t)(kc * 128 + w * 16) * NMODW + cg * 256 + lane * 4;
#pragma unroll
            for (int r = 0; r < 16; ++r) wv[r] = *(const f32x4*)(wp + (size_t)r * NMODW); }
        { int slot = 0;
          for (int it = F.vcu; it < NIT && slot < 3; it += F.G, ++slot) { const int kc = it / 48;
              for (int i = tid; i < 1024; i += 512) { const int kk = i >> 3, bb = i & 7; const float cv = A.c[bb * DM + kc * 128 + kk]; cact[slot * 1024 + kk * 8 + bb] = cv / (1.0f + __expf(-cv)); } } }
        __syncthreads();
        int slot = 0;
        for (int it = F.vcu; it < NIT; it += F.G, ++slot) {
            const int cg = it % 48, kc = it / 48;
            if (it + F.G < NIT) { const int itn = it + F.G, cgn = itn % 48, kcn = itn / 48; const float* wp = A.w_ada + (size_t)(kcn * 128 + w * 16) * NMODW + cgn * 256 + lane * 4;
#pragma unroll
                for (int r = 0; r < 16; ++r) wvn[r] = *(const f32x4*)(wp + (size_t)r * NMODW); }
            f32x4 acc[8];
#pragma unroll
            for (int bb = 0; bb < 8; ++bb) acc[bb] = (f32x4){0.f, 0.f, 0.f, 0.f};
            const LAS float* ca_ = cact + (slot % 3) * 1024;
#pragma unroll
            for (int r = 0; r < 16; ++r) {
                const f32x4 ca = *(const LAS f32x4*)(ca_ + (w * 16 + r) * 8), cb = *(const LAS f32x4*)(ca_ + (w * 16 + r) * 8 + 4);
                acc[0] += ca[0] * wv[r]; acc[1] += ca[1] * wv[r]; acc[2] += ca[2] * wv[r]; acc[3] += ca[3] * wv[r];
                acc[4] += cb[0] * wv[r]; acc[5] += cb[1] * wv[r]; acc[6] += cb[2] * wv[r]; acc[7] += cb[3] * wv[r];
            }
#pragma unroll
            for (int bb = 0; bb < 8; ++bb) *(LAS f32x4*)(red + (w * 8 + bb) * 256 + lane * 4) = acc[bb];
            __syncthreads();
            { const int bb = tid >> 6, col = (tid & 63) * 4; f32x4 sm = (f32x4){0.f, 0.f, 0.f, 0.f};
#pragma unroll
              for (int ww = 0; ww < 8; ++ww) sm += *(const LAS f32x4*)(red + (ww * 8 + bb) * 256 + col);
              *(f32x4*)(A.modp + (size_t)(kc * 8 + bb) * NMODW + cg * 256 + col) = sm; }
            __syncthreads();
#pragma unroll
            for (int r = 0; r < 16; ++r) wv[r] = wvn[r];
        }
    }
    {
        const int fr = lane & 15, g4 = lane >> 4;
        for (int u = F.vcu; u < 256; u += F.G) {
            const int g = u >> 6, k0 = (u & 63) * 32;
            f32x4 acc[2][2];
#pragma unroll
            for (int kt = 0; kt < 2; ++kt)
#pragma unroll
                for (int nt = 0; nt < 2; ++nt) acc[kt][nt] = (f32x4){0.f, 0.f, 0.f, 0.f};
            const float* ap = A.w_in + (size_t)(k0 + fr) * INW + g * 256 + 8 * g4;
            const float* bp = A.pool_w + (size_t)(g * 256 + 8 * g4) * 256 + 32 * w + fr;
#pragma unroll 2
            for (int s = 0; s < 8; ++s) {
                bf16x8 af[2], bq[2];
#pragma unroll
                for (int kt = 0; kt < 2; ++kt) { const f32x4 a0 = *(const f32x4*)(ap + (size_t)(16 * kt) * INW + 32 * s), a1 = *(const f32x4*)(ap + (size_t)(16 * kt) * INW + 32 * s + 4);
                    u32x4 t; t.x = pk2(a0[0], a0[1]); t.y = pk2(a0[2], a0[3]); t.z = pk2(a1[0], a1[1]); t.w = pk2(a1[2], a1[3]); af[kt] = __builtin_bit_cast(bf16x8, t); }
#pragma unroll
                for (int nt = 0; nt < 2; ++nt) { float bv[8];
#pragma unroll
                    for (int e = 0; e < 8; ++e) bv[e] = bp[(size_t)(32 * s + e) * 256 + 16 * nt];
                    u32x4 t; t.x = pk2(bv[0], bv[1]); t.y = pk2(bv[2], bv[3]); t.z = pk2(bv[4], bv[5]); t.w = pk2(bv[6], bv[7]); bq[nt] = __builtin_bit_cast(bf16x8, t); }
#pragma unroll
                for (int kt = 0; kt < 2; ++kt)
#pragma unroll
                    for (int nt = 0; nt < 2; ++nt) acc[kt][nt] = __builtin_amdgcn_mfma_f32_16x16x32_bf16(af[kt], bq[nt], acc[kt][nt], 0, 0, 0);
            }
#pragma unroll
            for (int nt = 0; nt < 2; ++nt) { const int n = 32 * w + 16 * nt + fr; const float sc = A.pool_scale[g * 256 + n];
#pragma unroll
                for (int kt = 0; kt < 2; ++kt) { u32x2 o; o.x = pk2(acc[kt][nt][0] * sc, acc[kt][nt][1] * sc); o.y = pk2(acc[kt][nt][2] * sc, acc[kt][nt][3] * sc);
                    *(GAS u32x2*)(A.WinT + (size_t)(g * 256 + n) * DM + k0 + 16 * kt + 4 * g4) = o; } }
        }
    }
    for (int idx = F.vcu * 512 + tid; idx < SEQ * 128; idx += F.G * 512) {
        const int pos = idx >> 7, j = idx & 127;
        const float t = (float)j / 127.0f;
        const float inv = ex2(-t * 13.287712379549449f);
        const double ang = (double)((float)pos * inv);
        const double kq = __builtin_rint(ang * 0.63661977236758134308);
        const double r = (ang - kq * 1.57079632679489655800) - kq * 6.12323399573676603587e-17;
        const double r2 = r * r;
        const double sn = r * (1.0 + r2 * (-1.0 / 6 + r2 * (1.0 / 120 + r2 * (-1.0 / 5040 + r2 * (1.0 / 362880 + r2 * (-1.0 / 39916800 + r2 * (1.0 / 6227020800.0)))))));
        const double cs = 1.0 + r2 * (-0.5 + r2 * (1.0 / 24 + r2 * (-1.0 / 720 + r2 * (1.0 / 40320 + r2 * (-1.0 / 3628800 + r2 * (1.0 / 479001600.0 + r2 * (-1.0 / 87178291200.0)))))));
        const int qd = ((int)kq) & 3;
        const double c = (qd == 0) ? cs : (qd == 1) ? -sn : (qd == 2) ? -cs : sn;
        const double s = (qd == 0) ? sn : (qd == 1) ? cs : (qd == 2) ? -sn : -cs;
        A.cosT[idx] = (float)c; A.sinT[idx] = (float)s;
    }
    {
        LAS float* scr = (LAS float*)(F.lds + w * 16384);
        const int gw = F.vcu * 8 + w, NGW = F.G * 8;
        constexpr int I_IN = (DM / 64) * ((INW - POOLW) / 32), I_O = (DM / 64) * (DM / 32), I_G = (DM / 64) * (FF / 32), I_D = (FF / 64) * (DM / 32);
        constexpr int NITEMS = I_IN + I_O + 2 * I_G + I_D;
        for (int it = gw; it < NITEMS; it += NGW) {
            int r = it;
            if (r < I_IN) { const int nblk = (INW - POOLW) / 32, kb = r / nblk, nb = r % nblk; if (nb >= 96) p0_transpose_item<true, false>(A.w_in + POOLW, INW, A.WinT, DM, kb * 64, nb * 32, POOLW + nb * 32, scr, lane); else p0_transpose_item<false, false>(A.w_in + POOLW, INW, A.WinT, DM, kb * 64, nb * 32, POOLW + nb * 32, scr, lane); continue; } r -= I_IN;
            if (r < I_O) { const int nblk = DM / 32, kb = r / nblk, nb = r % nblk; if (kb >= 16) p0_transpose_item<false, true>(A.w_out, DM, A.WoT, DM, kb * 64, nb * 32, nb * 32, scr, lane); else p0_transpose_item<false, false>(A.w_out, DM, A.WoT, DM, kb * 64, nb * 32, nb * 32, scr, lane); continue; } r -= I_O;
            if (r < I_G) { const int nblk = FF / 32, kb = r / nblk, nb = r % nblk; p0_transpose_item<false, false>(A.w_gate, FF, A.WguT, DM, kb * 64, nb * 32, 256 * (nb >> 2) + 32 * (nb & 3), scr, lane); continue; } r -= I_G;
            if (r < I_G) { const int nblk = FF / 32, kb = r / nblk, nb = r % nblk; p0_transpose_item<false, false>(A.w_up, FF, A.WguT, DM, kb * 64, nb * 32, 256 * (nb >> 2) + 128 + 32 * (nb & 3), scr, lane); continue; } r -= I_G;
            { const int nblk = DM / 32, kb = r / nblk, nb = r % nblk; p0_transpose_item<false, false>(A.w_down, DM, A.WdT, FF, kb * 64, nb * 32, nb * 32, scr, lane); }
        }
    }
}

template <int MODE>
__device__ __forceinline__ void norm_mod_phase(const Ctx& F, const float* src, bf16_t* dst, const float* gnorm, const float* modp, const float* b_ada, float* mod, int sh_idx, int sc_idx) {
    LAS float* Av = (LAS float*)(F.lds); LAS float* Bv = (LAS float*)(F.lds + 8192);
    for (int blk = F.vcu; blk < MTOK / 64; blk += F.G) {
        const int b = blk >> 5;
        const int row0 = blk * 64 + F.wave * 8;
        f32x4 v[8], vn[8];
        { const GAS f32x4* xr = (const GAS f32x4*)(src + (size_t)row0 * DM) + F.lane;
#pragma unroll
          for (int j = 0; j < 8; ++j) v[j] = xr[64 * j]; }
        __syncthreads();
        for (int k = F.tid; k < DM; k += 512) {
            float sc, sh;
            if (MODE == 0) {
                sc = b_ada[sc_idx * DM + k]; sh = b_ada[sh_idx * DM + k];
#pragma unroll 4
                for (int kc = 0; kc < ADA_KC; ++kc) { sc += modp[(size_t)(kc * 8 + b) * NMODW + sc_idx * DM + k]; sh += modp[(size_t)(kc * 8 + b) * NMODW + sh_idx * DM + k]; }
            } else { sc = mod[(size_t)b * NMODW + sc_idx * DM + k]; sh = mod[(size_t)b * NMODW + sh_idx * DM + k]; }
            Av[k] = gnorm[k] * (1.0f + sc); Bv[k] = sh;
        }
        if (MODE == 0) {
            if (F.tid < 384) { const int idx = blk * 384 + F.tid, bb = idx / NMODW, n = idx % NMODW; float s = b_ada[n];
#pragma unroll 4
                for (int kc = 0; kc < ADA_KC; ++kc) s += modp[(size_t)(kc * 8 + bb) * NMODW + n];
                mod[idx] = s; }
        }
        __syncthreads();
        {
            for (int i = 0; i < 8; ++i) {
                const int row = row0 + i;
                if (i < 7) { const GAS f32x4* xr = (const GAS f32x4*)(src + (size_t)(row + 1) * DM) + F.lane;
#pragma unroll
                    for (int j = 0; j < 8; ++j) vn[j] = xr[64 * j]; }
                float s = 0.f;
#pragma unroll
                for (int j = 0; j < 8; ++j) s += (v[j][0] * v[j][0] + v[j][1] * v[j][1]) + (v[j][2] * v[j][2] + v[j][3] * v[j][3]);
                const float rstd = 1.0f / sqrtf(wave_sum(s) * (1.0f / DM) + EPS);
                GAS u32x2* o8 = (GAS u32x2*)(dst + (size_t)row * DM) + F.lane;
#pragma unroll
                for (int j = 0; j < 8; ++j) { const f32x4 a = *(const LAS f32x4*)(Av + 4 * F.lane + 256 * j), bb = *(const LAS f32x4*)(Bv + 4 * F.lane + 256 * j);
                    const f32x4 o = v[j] * rstd * a + bb; u32x2 wv; wv.x = pk2(o[0], o[1]); wv.y = pk2(o[2], o[3]); o8[64 * j] = wv; }
#pragma unroll
                for (int j = 0; j < 8; ++j) v[j] = vn[j];
            }
        }
    }
}

__device__ __forceinline__ void norm_mod_bf16_phase(const Ctx& F, const bf16_t* src, bf16_t* dst, const float* gnorm, const float* mod, int sh_idx, int sc_idx) {
    LAS float* Av = (LAS float*)(F.lds); LAS float* Bv = (LAS float*)(F.lds + 8192);
    for (int blk = F.vcu; blk < MTOK / 64; blk += F.G) {
        const int b = blk >> 5;
        __syncthreads();
        for (int k = F.tid; k < DM; k += 512) { const float sc = mod[(size_t)b * NMODW + sc_idx * DM + k], sh = mod[(size_t)b * NMODW + sh_idx * DM + k]; Av[k] = gnorm[k] * (1.0f + sc); Bv[k] = sh; }
        __syncthreads();
        const int row0 = blk * 64 + F.wave * 8;
        u32x4 v[4], vn[4];
        { const GAS u32x4* xr = (const GAS u32x4*)(src + (size_t)row0 * DM) + F.lane;
#pragma unroll
          for (int j = 0; j < 4; ++j) v[j] = xr[64 * j]; }
        for (int i = 0; i < 8; ++i) {
            const int row = row0 + i;
            if (i < 7) { const GAS u32x4* xr = (const GAS u32x4*)(src + (size_t)(row + 1) * DM) + F.lane;
#pragma unroll
                for (int j = 0; j < 4; ++j) vn[j] = xr[64 * j]; }
            float f[4][8]; float s = 0.f;
#pragma unroll
            for (int j = 0; j < 4; ++j) { f[j][0] = bflo(v[j].x); f[j][1] = bfhi(v[j].x); f[j][2] = bflo(v[j].y); f[j][3] = bfhi(v[j].y); f[j][4] = bflo(v[j].z); f[j][5] = bfhi(v[j].z); f[j][6] = bflo(v[j].w); f[j][7] = bfhi(v[j].w);
#pragma unroll
                for (int e = 0; e < 8; ++e) s += f[j][e] * f[j][e]; }
            const float rstd = 1.0f / sqrtf(wave_sum(s) * (1.0f / DM) + EPS);
            GAS u32x4* o16 = (GAS u32x4*)(dst + (size_t)row * DM) + F.lane;
#pragma unroll
            for (int j = 0; j < 4; ++j) { const LAS float* ap = Av + 8 * F.lane + 512 * j; const LAS float* bp = Bv + 8 * F.lane + 512 * j;
                const f32x4 a0 = *(const LAS f32x4*)ap, a1 = *(const LAS f32x4*)(ap + 4), b0 = *(const LAS f32x4*)bp, b1 = *(const LAS f32x4*)(bp + 4);
                u32x4 w; w.x = pk2(f[j][0] * rstd * a0[0] + b0[0], f[j][1] * rstd * a0[1] + b0[1]); w.y = pk2(f[j][2] * rstd * a0[2] + b0[2], f[j][3] * rstd * a0[3] + b0[3]);
                w.z = pk2(f[j][4] * rstd * a1[0] + b1[0], f[j][5] * rstd * a1[1] + b1[1]); w.w = pk2(f[j][6] * rstd * a1[2] + b1[2], f[j][7] * rstd * a1[3] + b1[3]);
                o16[64 * j] = w; }
#pragma unroll
            for (int j = 0; j < 4; ++j) v[j] = vn[j];
        }
    }
}

__device__ __forceinline__ void final_norm_phase(const Ctx& F, const bf16_t* src, float* out, const float* g) {
    const int gw = F.vcu * 8 + F.wave, NGW = F.G * 8;
    static_assert(MTOK % 2048 == 0, "rows per wave");
    for (int r0 = gw; r0 < MTOK; r0 += NGW * 8) {
        u32x4 v[8][4];
#pragma unroll
        for (int i = 0; i < 8; ++i) { const GAS u32x4* xr = (const GAS u32x4*)(src + (size_t)(r0 + i * NGW) * DM) + F.lane;
#pragma unroll
            for (int j = 0; j < 4; ++j) v[i][j] = (r0 + i * NGW < MTOK) ? xr[64 * j] : (u32x4){0u, 0u, 0u, 0u}; }
#pragma unroll
        for (int i = 0; i < 8; ++i) {
            const int row = r0 + i * NGW;
            if (row < MTOK) {
                float f[4][8]; float s = 0.f;
#pragma unroll
                for (int j = 0; j < 4; ++j) { f[j][0] = bflo(v[i][j].x); f[j][1] = bfhi(v[i][j].x); f[j][2] = bflo(v[i][j].y); f[j][3] = bfhi(v[i][j].y); f[j][4] = bflo(v[i][j].z); f[j][5] = bfhi(v[i][j].z); f[j][6] = bflo(v[i][j].w); f[j][7] = bfhi(v[i][j].w);
#pragma unroll
                    for (int e = 0; e < 8; ++e) s += f[j][e] * f[j][e]; }
                const float rstd = 1.0f / sqrtf(wave_sum(s) * (1.0f / DM) + EPS);
                float* orow = out + (size_t)row * DM + 8 * F.lane;
#pragma unroll
                for (int j = 0; j < 4; ++j) { const f32x4 g0 = *(const f32x4*)(g + 8 * F.lane + 512 * j), g1 = *(const f32x4*)(g + 8 * F.lane + 512 * j + 4);
                    f32x4 o0, o1;
#pragma unroll
                    for (int e = 0; e < 4; ++e) { o0[e] = f[j][e] * rstd * g0[e]; o1[e] = f[j][4 + e] * rstd * g1[e]; }
                    *(f32x4*)(orow + 512 * j) = o0; *(f32x4*)(orow + 512 * j + 4) = o1; }
            }
        }
    }
}

__device__ __forceinline__ void pool_phase(const Ctx& F, const bf16_t* proj, bf16_t* cat) {
    LAS unsigned char* T = F.lds;
    for (int blk = F.vcu; blk < MTOK / 64; blk += F.G) {
        const int b = blk >> 5, tb = (blk & 31) * 64;
        for (int hc = 0; hc < 2; ++hc) {
            int tid = F.tid; asm volatile("" : "+v"(tid));
            __syncthreads();
            { u32x4 r[10];
#pragma unroll
              for (int i = 0; i < 10; ++i) { const int idx = tid + 512 * i, row = idx >> 6, chn = idx & 63, gt = tb - 8 + row;
                  r[i] = (u32x4){0u, 0u, 0u, 0u};
                  if (gt >= 0 && gt < SEQ) r[i] = *(const u32x4*)(proj + ((size_t)b * SEQ + gt) * INW + hc * 512 + chn * 8); }
#pragma unroll
              for (int i = 0; i < 10; ++i) { const int idx = tid + 512 * i; *(LAS u32x4*)(T + idx * 16) = r[i]; } }
            __syncthreads();
            const int cgl = tid & 63, rg = tid >> 6;
            const int half = 1 << (hc * 2 + (cgl >> 5));
            const int t0 = tb + rg * 8;
            LAS unsigned char* col = T + cgl * 16;
            float S[8];
#pragma unroll
            for (int e = 0; e < 8; ++e) S[e] = 0.f;
            { const int lo = (t0 - half) > 0 ? (t0 - half) : 0, hi = (t0 + half) < SEQ ? (t0 + half) : SEQ;
              for (int j = lo; j < hi; ++j) { const u32x4 v = *(const LAS u32x4*)(col + (j - tb + 8) * 1024);
                  S[0] += bflo(v.x); S[1] += bfhi(v.x); S[2] += bflo(v.y); S[3] += bfhi(v.y); S[4] += bflo(v.z); S[5] += bfhi(v.z); S[6] += bflo(v.w); S[7] += bfhi(v.w); } }
#pragma unroll
            for (int i = 0; i < 8; ++i) {
                const int t = t0 + i;
                const int lo = (t - half) > 0 ? (t - half) : 0, hi = (t + half) < SEQ ? (t + half) : SEQ;
                const float rc = 1.0f / (float)(hi - lo);
                const u32x4 v = *(const LAS u32x4*)(col + (t - tb + 8) * 1024);
                u32x4 o;
                o.x = pk2(S[0] * rc - bflo(v.x), S[1] * rc - bfhi(v.x)); o.y = pk2(S[2] * rc - bflo(v.y), S[3] * rc - bfhi(v.y));
                o.z = pk2(S[4] * rc - bflo(v.z), S[5] * rc - bfhi(v.z)); o.w = pk2(S[6] * rc - bflo(v.w), S[7] * rc - bfhi(v.w));
                *(u32x4*)(cat + ((size_t)b * SEQ + t) * DM + hc * 512 + cgl * 8) = o;
                if (t + half < SEQ) { const u32x4 a = *(const LAS u32x4*)(col + (t + half - tb + 8) * 1024);
                    S[0] += bflo(a.x); S[1] += bfhi(a.x); S[2] += bflo(a.y); S[3] += bfhi(a.y); S[4] += bflo(a.z); S[5] += bfhi(a.z); S[6] += bflo(a.w); S[7] += bfhi(a.w); }
                if (t - half >= 0) { const u32x4 a = *(const LAS u32x4*)(col + (t - half - tb + 8) * 1024);
                    S[0] -= bflo(a.x); S[1] -= bfhi(a.x); S[2] -= bflo(a.y); S[3] -= bfhi(a.y); S[4] -= bflo(a.z); S[5] -= bfhi(a.z); S[6] -= bflo(a.w); S[7] -= bfhi(a.w); }
            }
        }
    }
    __syncthreads();
}

constexpr int RS = 544;
constexpr int RSV = 160;
__device__ __forceinline__ bf16x8 tr_pair(LAS unsigned char* p0, LAS unsigned char* p1) {
    const s16x4 a = __builtin_amdgcn_ds_read_tr16_b64_v4i16((LAS s16x4*)p0), b = __builtin_amdgcn_ds_read_tr16_b64_v4i16((LAS s16x4*)p1);
    return __builtin_shufflevector(a, b, 0, 1, 2, 3, 4, 5, 6, 7);
}
__device__ __forceinline__ bf16x8 pack8(const f32x4 a, const f32x4 b) {
    u32x4 w; w.x = pk2(a[0], a[1]); w.y = pk2(a[2], a[3]); w.z = pk2(b[0], b[1]); w.w = pk2(b[2], b[3]);
    return __builtin_bit_cast(bf16x8, w);
}

__device__ __forceinline__ void ret_chain_phase(const Ctx& F, const bf16_t* proj, bf16_t* yp, const float* dec_f, const float* dec_b) {
    LAS unsigned char* KT = F.lds; LAS unsigned char* VT = F.lds + 128 * RS; LAS unsigned char* ST = F.lds + 128 * RS + 128 * RSV;
    const int w = F.wave;
    for (int ch = F.vcu; ch < 256; ch += F.G) {
        int tid = F.tid; asm volatile("" : "+v"(tid));
        const int lane = tid & 63, fr = lane & 15, g4 = lane >> 4, q = fr >> 2, p = fr & 3;
        const int bh = ch >> 3, b = bh >> 2, h = bh & 3, dir = (ch >> 2) & 1, slab = ch & 3;
        const float lg = -__expf(dir ? dec_b[h] : dec_f[h]);
        const float l2 = lg * 1.44269504088896341f;
        f32x4 S[2][4];
#pragma unroll
        for (int dd = 0; dd < 2; ++dd)
#pragma unroll
            for (int et = 0; et < 4; ++et) S[dd][et] = (f32x4){0.f, 0.f, 0.f, 0.f};
        __syncthreads();
        for (int i = tid; i < 64 * RS / 16; i += 512) *(LAS u32x4*)(ST + i * 16) = (u32x4){0u, 0u, 0u, 0u};
        const float cdec = ex2(128.0f * l2);
        const int krow = tid >> 5, kc16 = tid & 31, vrow = tid >> 3, vc16 = tid & 7;
        u32x4 kreg[8], vreg[2]; bf16x8 qreg[8];
#define RC_PTRS(STEP) const int n_ = dir ? (NCHK - 1 - (STEP)) : (STEP); const size_t mm = (size_t)b * SEQ + (size_t)n_ * CHK; \
            const bf16_t* kp_ = proj + (mm + krow) * INW + 2048 + 256 * h + kc16 * 8; \
            const bf16_t* vp_ = proj + (mm + vrow) * INW + 3072 + 256 * h + 64 * slab + vc16 * 8; \
            const bf16_t* qp_ = proj + (mm + 16 * w + fr) * INW + 1024 + 256 * h + 8 * g4;
#define RC_LOAD_K(I0) do { kreg[(I0)] = *(const u32x4*)(kp_ + (size_t)(16 * (I0)) * INW); kreg[(I0) + 1] = *(const u32x4*)(kp_ + (size_t)(16 * ((I0) + 1)) * INW); } while (0)
#define RC_LOAD_Q(S0) do { qreg[(S0)] = *(const bf16x8*)(qp_ + 32 * (S0)); qreg[(S0) + 1] = *(const bf16x8*)(qp_ + 32 * ((S0) + 1)); } while (0)
#define RC_LOAD_V() do { vreg[0] = *(const u32x4*)(vp_); vreg[1] = *(const u32x4*)(vp_ + (size_t)64 * INW); } while (0)
        { RC_PTRS(0); RC_LOAD_K(0); RC_LOAD_K(2); RC_LOAD_K(4); RC_LOAD_K(6); RC_LOAD_V(); RC_LOAD_Q(0); RC_LOAD_Q(2); RC_LOAD_Q(4); RC_LOAD_Q(6); }
        for (int step = 0; step < NCHK; ++step) {
            const int n = dir ? (NCHK - 1 - step) : step;
            const size_t m0 = (size_t)b * SEQ + (size_t)n * CHK;
#pragma unroll
            for (int i = 0; i < 8; ++i) *(LAS u32x4*)(KT + (krow + 16 * i) * RS + kc16 * 16) = kreg[i];
#pragma unroll
            for (int i = 0; i < 2; ++i) { const int row = vrow + 64 * i; const u32x4 v = vreg[i];
                const float kd = ex2((float)(dir ? row : (CHK - 1 - row)) * l2);
                u32x4 o; o.x = pk2(bflo(v.x) * kd, bfhi(v.x) * kd); o.y = pk2(bflo(v.y) * kd, bfhi(v.y) * kd); o.z = pk2(bflo(v.z) * kd, bfhi(v.z) * kd); o.w = pk2(bflo(v.w) * kd, bfhi(v.w) * kd);
                *(LAS u32x4*)(VT + row * RSV + vc16 * 16) = o; }
            bf16x8 qf[8];
#pragma unroll
            for (int s = 0; s < 8; ++s) qf[s] = qreg[s];
            __syncthreads();
            const bool more = step + 1 < NCHK;
            RC_PTRS(more ? step + 1 : step);
            { f32x4 y[4];
              bf16x8 sfb[2][8];
#pragma unroll
              for (int s = 0; s < 8; ++s) sfb[0][s] = *(const LAS bf16x8*)(ST + (fr) * RS + (32 * s + 8 * g4) * 2);
#pragma unroll
              for (int et = 0; et < 4; ++et) { y[et] = (f32x4){0.f, 0.f, 0.f, 0.f};
                  if (et < 3) {
#pragma unroll
                      for (int s = 0; s < 8; ++s) sfb[(et + 1) & 1][s] = *(const LAS bf16x8*)(ST + (16 * (et + 1) + fr) * RS + (32 * s + 8 * g4) * 2); }
#pragma unroll
                  for (int s = 0; s < 8; ++s) y[et] = __builtin_amdgcn_mfma_f32_16x16x32_bf16(sfb[et & 1][s], qf[s], y[et], 0, 0, 0);
                  if (more) RC_LOAD_K(2 * et);
                  __builtin_amdgcn_sched_barrier(0); }
              const int ii = 16 * w + fr;
              const float a = ex2((float)(dir ? (CHK - ii) : (ii + 1)) * l2);
              bf16_t* yo = yp + ((size_t)dir * MTOK + m0 + ii) * 1024 + 256 * h + 64 * slab + 8 * g4;
#pragma unroll
              for (int jp = 0; jp < 2; ++jp) { u32x4 o; o.x = pk2(y[2 * jp][0] * a, y[2 * jp][1] * a); o.y = pk2(y[2 * jp][2] * a, y[2 * jp][3] * a);
                  o.z = pk2(y[2 * jp + 1][0] * a, y[2 * jp + 1][1] * a); o.w = pk2(y[2 * jp + 1][2] * a, y[2 * jp + 1][3] * a); *(u32x4*)(yo + 32 * jp) = o; } }
            if (step < NCHK - 1) {
#pragma unroll
                for (int dd = 0; dd < 2; ++dd)
#pragma unroll
                    for (int et = 0; et < 4; ++et) S[dd][et] *= cdec;
                bf16x8 kfb[2][2], vfb[2][4];
#define RC_FRAGS(BUF, SS) do { _Pragma("unroll") for (int dd = 0; dd < 2; ++dd) { LAS unsigned char* a0 = KT + (32 * (SS) + 8 * g4 + q) * RS + (32 * w + 16 * dd + 4 * p) * 2; kfb[BUF][dd] = tr_pair(a0, a0 + 4 * RS); } \
                    _Pragma("unroll") for (int et = 0; et < 4; ++et) { LAS unsigned char* b0 = VT + (32 * (SS) + 8 * g4 + q) * RSV + (16 * et + 4 * p) * 2; vfb[BUF][et] = tr_pair(b0, b0 + 4 * RSV); } } while (0)
                RC_FRAGS(0, 0);
#pragma unroll
                for (int s = 0; s < 4; ++s) {
                    if (s < 3) RC_FRAGS((s + 1) & 1, s + 1);
#pragma unroll
                    for (int dd = 0; dd < 2; ++dd)
#pragma unroll
                        for (int et = 0; et < 4; ++et) S[dd][et] = __builtin_amdgcn_mfma_f32_16x16x32_bf16(kfb[s & 1][dd], vfb[s & 1][et], S[dd][et], 0, 0, 0);
                    RC_LOAD_Q(2 * s); if (s == 0) RC_LOAD_V();
                    __builtin_amdgcn_sched_barrier(0);
                }
#undef RC_FRAGS
            }
            __syncthreads();
            if (step < NCHK - 1) {
#pragma unroll
                for (int dd = 0; dd < 2; ++dd)
#pragma unroll
                    for (int et = 0; et < 4; ++et) { u32x2 o; o.x = pk2(S[dd][et][0], S[dd][et][1]); o.y = pk2(S[dd][et][2], S[dd][et][3]);
                        *(LAS u32x2*)(ST + (16 * et + fr) * RS + (32 * w + 16 * dd + 4 * g4) * 2) = o; }
            }
        }
#undef RC_PTRS
#undef RC_LOAD_K
#undef RC_LOAD_Q
#undef RC_LOAD_V
    }
}

__device__ __forceinline__ void ret_out_phase(const Ctx& F, const bf16_t* proj, const bf16_t* yp, bf16_t* cat, const float* dec_f, const float* dec_b) {
    LAS unsigned char* KT = F.lds; LAS unsigned char* VT = F.lds + 128 * RS;
    const int tid_ = F.tid, w = F.wave;
    for (int u = F.vcu; u < BATCH * NHEAD * NCHK; u += F.G) {
        const int bh = u >> 4, b = bh >> 2, h = bh & 3, n = u & 15;
        const size_t m0 = (size_t)b * SEQ + (size_t)n * CHK;
        const float lf2 = -__expf(dec_f[h]) * 1.44269504088896341f, lb2 = -__expf(dec_b[h]) * 1.44269504088896341f;
        int tid = tid_; asm volatile("" : "+v"(tid));
        const int lane = tid & 63, fr = lane & 15, g4 = lane >> 4, q = fr >> 2, p = fr & 3;
        const size_t m = m0 + 16 * w + fr;
        bf16x8 qf[8];
        { u32x4 kreg[8], vreg[8];
          const int row = tid >> 5, c16 = tid & 31;
          const bf16_t* kp = proj + (m0 + row) * INW + 2048 + 256 * h + c16 * 8; const bf16_t* vp = kp + 1024;
#pragma unroll
          for (int i = 0; i < 8; ++i) kreg[i] = *(const u32x4*)(kp + (size_t)(16 * i) * INW);
#pragma unroll
          for (int i = 0; i < 8; ++i) vreg[i] = *(const u32x4*)(vp + (size_t)(16 * i) * INW);
          const bf16_t* qp = proj + m * INW + 1024 + 256 * h + 8 * g4;
#pragma unroll
          for (int s = 0; s < 8; ++s) qf[s] = *(const bf16x8*)(qp + 32 * s);
          __syncthreads();
#pragma unroll
          for (int i = 0; i < 8; ++i) *(LAS u32x4*)(KT + (row + 16 * i) * RS + c16 * 16) = kreg[i];
#pragma unroll
          for (int i = 0; i < 8; ++i) *(LAS u32x4*)(VT + (row + 16 * i) * RS + c16 * 16) = vreg[i]; }
        __syncthreads();
        u32x4 yfq[8], ybq[8], gq[8];
        { const bf16_t* yf = yp + m * 1024 + 256 * h + 8 * g4; const bf16_t* yb = yp + ((size_t)MTOK + m) * 1024 + 256 * h + 8 * g4; const bf16_t* gp = proj + m * INW + 4096 + 256 * h + 8 * g4;
#pragma unroll
          for (int j = 0; j < 8; ++j) { yfq[j] = *(const u32x4*)(yf + 32 * j); ybq[j] = *(const u32x4*)(yb + 32 * j); gq[j] = *(const u32x4*)(gp + 32 * j); } }
        bf16x8 pb[4];
        {
            f32x4 pt[8];
            bf16x8 kfb[2][8];
#pragma unroll
            for (int s = 0; s < 8; ++s) kfb[0][s] = *(const LAS bf16x8*)(KT + (fr) * RS + (32 * s + 8 * g4) * 2);
#pragma unroll
            for (int jt = 0; jt < 8; ++jt) { pt[jt] = (f32x4){0.f, 0.f, 0.f, 0.f};
                if (jt < 7) {
#pragma unroll
                    for (int s = 0; s < 8; ++s) kfb[(jt + 1) & 1][s] = *(const LAS bf16x8*)(KT + (16 * (jt + 1) + fr) * RS + (32 * s + 8 * g4) * 2); }
#pragma unroll
                for (int s = 0; s < 8; ++s) pt[jt] = __builtin_amdgcn_mfma_f32_16x16x32_bf16(kfb[jt & 1][s], qf[s], pt[jt], 0, 0, 0);
                __builtin_amdgcn_sched_barrier(0); }
            const int il = 16 * w + fr;
#pragma unroll
            for (int jt = 0; jt < 8; ++jt)
#pragma unroll
                for (int r = 0; r < 4; ++r) { const int df = il - (16 * jt + 4 * g4 + r);
                    const float dcy = df >= 0 ? ex2((float)df * lf2) : ex2((float)(-df) * lb2);
                    pt[jt][r] *= dcy; }
#pragma unroll
            for (int s = 0; s < 4; ++s) pb[s] = pack8(pt[2 * s], pt[2 * s + 1]);
        }
        f32x4 ot[16];
#pragma unroll
        for (int et = 0; et < 16; ++et) ot[et] = (f32x4){0.f, 0.f, 0.f, 0.f};
        {
            bf16x8 vfb[2][8];
#define RO_FRAGS(BUF, B8) do { _Pragma("unroll") for (int e8 = 0; e8 < 8; ++e8) { LAS unsigned char* a0 = VT + (32 * ((B8) >> 1) + 4 * g4 + q) * RS + (16 * (8 * ((B8) & 1) + e8) + 4 * p) * 2; vfb[BUF][e8] = tr_pair(a0, a0 + 16 * RS); } } while (0)
            RO_FRAGS(0, 0);
#pragma unroll
            for (int b8 = 0; b8 < 8; ++b8) {
                if (b8 < 7) RO_FRAGS((b8 + 1) & 1, b8 + 1);
#pragma unroll
                for (int e8 = 0; e8 < 8; ++e8) ot[8 * (b8 & 1) + e8] = __builtin_amdgcn_mfma_f32_16x16x32_bf16(vfb[b8 & 1][e8], pb[b8 >> 1], ot[8 * (b8 & 1) + e8], 0, 0, 0);
                __builtin_amdgcn_sched_barrier(0);
            }
#undef RO_FRAGS
        }
        float ss = 0.f;
#pragma unroll
        for (int j = 0; j < 8; ++j) {
            ot[2 * j][0] += bflo(yfq[j].x) + bflo(ybq[j].x); ot[2 * j][1] += bfhi(yfq[j].x) + bfhi(ybq[j].x); ot[2 * j][2] += bflo(yfq[j].y) + bflo(ybq[j].y); ot[2 * j][3] += bfhi(yfq[j].y) + bfhi(ybq[j].y);
            ot[2 * j + 1][0] += bflo(yfq[j].z) + bflo(ybq[j].z); ot[2 * j + 1][1] += bfhi(yfq[j].z) + bfhi(ybq[j].z); ot[2 * j + 1][2] += bflo(yfq[j].w) + bflo(ybq[j].w); ot[2 * j + 1][3] += bfhi(yfq[j].w) + bfhi(ybq[j].w);
#pragma unroll
            for (int t = 0; t < 2; ++t) ss += (ot[2 * j + t][0] * ot[2 * j + t][0] + ot[2 * j + t][1] * ot[2 * j + t][1]) + (ot[2 * j + t][2] * ot[2 * j + t][2] + ot[2 * j + t][3] * ot[2 * j + t][3]); }
        ss += __shfl_xor(ss, 16); ss += __shfl_xor(ss, 32);
        const float rstd = 1.0f / sqrtf(ss * (1.0f / DH) + EPS);
        bf16_t* op = cat + m * DM + 1024 + 256 * h + 8 * g4;
#pragma unroll
        for (int j = 0; j < 8; ++j) {
            u32x4 o;
            o.x = pk2(pg8::fast_silu(bflo(gq[j].x)) * ot[2 * j][0] * rstd, pg8::fast_silu(bfhi(gq[j].x)) * ot[2 * j][1] * rstd);
            o.y = pk2(pg8::fast_silu(bflo(gq[j].y)) * ot[2 * j][2] * rstd, pg8::fast_silu(bfhi(gq[j].y)) * ot[2 * j][3] * rstd);
            o.z = pk2(pg8::fast_silu(bflo(gq[j].z)) * ot[2 * j + 1][0] * rstd, pg8::fast_silu(bfhi(gq[j].z)) * ot[2 * j + 1][1] * rstd);
            o.w = pk2(pg8::fast_silu(bflo(gq[j].w)) * ot[2 * j + 1][2] * rstd, pg8::fast_silu(bfhi(gq[j].w)) * ot[2 * j + 1][3] * rstd);
            *(u32x4*)(op + 32 * j) = o; }
    }
}

constexpr int NPHASE = 10;
struct Args { const float* in[16]; float* out; unsigned char* ws; int ph_lo, ph_hi; };
__global__ void __launch_bounds__(512, 2) fwd_kernel(Args args) {
    extern __shared__ __attribute__((aligned(16))) unsigned char lds_raw[];
    Ctx F;
    F.lds = (LAS unsigned char*)lds_raw;
    F.tid = threadIdx.x; F.lane = F.tid & 63; F.wave = __builtin_amdgcn_readfirstlane(F.tid >> 6);
    F.G = gridDim.x; { const int bx = blockIdx.x; F.vcu = (F.G % 8 == 0) ? (bx % 8) * (F.G / 8) + bx / 8 : bx; }
    unsigned char* ws = args.ws;
    gu32* ctl = (gu32*)(ws + WS_CTL);
    volatile LAS unsigned* MISC = (volatile LAS unsigned*)(F.lds + LDSCTL_OFF);
    for (int u = F.tid; u < (LDS_BYTES - LDSCTL_OFF) / 4; u += 512) ((LAS unsigned*)(F.lds + LDSCTL_OFF))[u] = 0u;
    __syncthreads();
    const int lo = args.ph_lo, hi = args.ph_hi;
    const bool multi = (hi - lo) > 1;
    XcdBarrier bar; bar.bar = (unsigned*)(ctl + CW_BAR); bar.x = 0; bar.st = nullptr;
    if (multi) bar = xcd_barrier_post((unsigned*)(ctl + CW_BAR), MISC + 8);
#ifndef PHASE_MASK
#define PHASE_MASK 0x3ff
#endif
#define IN(k) (((PHASE_MASK >> (k)) & 1) && lo <= (k) && (k) < hi)
#define SEAM(k) do { if (IN(k) && IN((k) + 1)) xcd_barrier(bar); { int t_ = threadIdx.x; asm volatile("" : "+v"(t_)); F.tid = t_; F.lane = t_ & 63; F.wave = __builtin_amdgcn_readfirstlane(t_ >> 6); } } while (0)
    const float* x = args.in[0]; const float* c = args.in[1]; const float* w_ada = args.in[2]; const float* b_ada = args.in[3]; const float* norm1_g = args.in[4];
    const float* w_in = args.in[5]; const float* pool_w = args.in[6]; const float* pool_scale = args.in[7]; const float* dec_f = args.in[8]; const float* dec_b = args.in[9];
    const float* w_out = args.in[10]; const float* norm2_g = args.in[11]; const float* w_gate = args.in[12]; const float* w_up = args.in[13]; const float* w_down = args.in[14]; const float* final_g = args.in[15];
    float* out = args.out;
    bf16_t* WinT = (bf16_t*)(ws + WS_WIN); bf16_t* WoT = (bf16_t*)(ws + WS_WO); bf16_t* WguT = (bf16_t*)(ws + WS_WGU); bf16_t* WdT = (bf16_t*)(ws + WS_WD);
    float* modp = (float*)(ws + WS_MODP); float* mod = (float*)(ws + WS_MOD); float* cosT = (float*)(ws + WS_ROPE); float* sinT = cosT + SEQ * 128;
    bf16_t* H = (bf16_t*)(ws + WS_H); bf16_t* CAT = (bf16_t*)(ws + WS_CAT); bf16_t* PROJ = (bf16_t*)(ws + WS_PROJ); bf16_t* ACT = (bf16_t*)(ws + WS_ACT);
    bf16_t* X1 = (bf16_t*)out;
    bf16_t* X2 = (bf16_t*)(ws + WS_H);

#ifndef REPEAT_MASK
#define REPEAT_MASK 0
#endif
#define REP(k) for (int rep_ = 0; rep_ < 1 + ((REPEAT_MASK >> (k)) & 1); ++rep_)
    if (IN(0)) REP(0) { P0Args A{c, w_ada, w_in, pool_w, pool_scale, w_out, w_gate, w_up, w_down, WinT, WoT, WguT, WdT, modp, cosT, sinT}; p0_prologue(F, A); __syncthreads(); }
    SEAM(0);
    if (IN(1)) REP(1) { norm_mod_phase<0>(F, x, H, norm1_g, modp, b_ada, mod, 0, 1); }
    SEAM(1);
    if (IN(2)) REP(2) { pg8::Gemm g{H, WinT, MTOK, INW, DM}; pg8::StaticOrder S; S.init(MTOK, INW, F.G, (int)blockIdx.x); pg8::EpiProj E{PROJ, cosT, sinT};
        pg8::gemm_phase<pg8::EpiProj, pg8::StaticOrder, true, true>(F.lds, g, S, E); }
    SEAM(2);
    if (IN(3)) REP(3) { pool_phase(F, PROJ, CAT); ret_chain_phase(F, PROJ, (bf16_t*)out, dec_f, dec_b); }
    SEAM(3);
    if (IN(4)) REP(4) { ret_out_phase(F, PROJ, (const bf16_t*)out, CAT, dec_f, dec_b); }
    SEAM(4);
    if (IN(5)) REP(5) { pg8::Gemm g{CAT, WoT, MTOK, DM, DM}; pg8::StaticOrder S; S.init(MTOK, DM, F.G, (int)blockIdx.x); pg8::EpiRes<false> E{x, X1, mod + 2 * DM};
        pg8::gemm_phase<pg8::EpiRes<false>, pg8::StaticOrder, true, true>(F.lds, g, S, E); }
    SEAM(5);
    if (IN(6)) REP(6) { norm_mod_bf16_phase(F, X1, H, norm2_g, mod, 3, 4); }
    SEAM(6);
    if (IN(7)) REP(7) { pg8::Gemm g{H, WguT, MTOK, 2 * FF, DM}; pg8::StaticOrder S; S.init(MTOK, 2 * FF, F.G, (int)blockIdx.x); pg8::EpiSwiGLU E{ACT};
        pg8::gemm_phase<pg8::EpiSwiGLU, pg8::StaticOrder, true, true>(F.lds, g, S, E); }
    SEAM(7);
    if (IN(8)) REP(8) { pg8::Gemm g{ACT, WdT, MTOK, DM, FF}; pg8::StaticOrder S; S.init(MTOK, DM, F.G, (int)blockIdx.x); pg8::EpiRes<true> E{X1, X2, mod + 5 * DM};
        pg8::gemm_phase<pg8::EpiRes<true>, pg8::StaticOrder, true, true>(F.lds, g, S, E); }
    SEAM(8);
    if (IN(9)) REP(9) { final_norm_phase(F, X2, out, final_g); }
#undef IN
#undef SEAM
}

#ifndef MK_PER_PHASE
#define MK_PER_PHASE 0
#endif
extern "C" void kernel_launch(void* const* d_in, const int* in_sizes, int n_in, void* d_out, int out_size, void* d_ws, size_t ws_size, hipStream_t stream) {
    static int grid = 0;
    if (grid == 0) {
        if (n_in != 16 || in_sizes[0] != MTOK * DM || out_size != MTOK * DM || ws_size < WS_END) { fprintf(stderr, "kernel_launch: unexpected shapes (n_in %d, in0 %d, out %d, ws %zu)\n", n_in, n_in > 0 ? in_sizes[0] : -1, out_size, ws_size); grid = -1; return; }
        int dev = 0, cus = 0, per_cu = 0;
        if (hipGetDevice(&dev) != hipSuccess || hipDeviceGetAttribute(&cus, hipDeviceAttributeMultiprocessorCount, dev) != hipSuccess) { grid = -1; return; }
        if (hipFuncSetAttribute((const void*)fwd_kernel, hipFuncAttributeMaxDynamicSharedMemorySize, LDS_BYTES) != hipSuccess) { fprintf(stderr, "kernel_launch: hipFuncSetAttribute failed\n"); grid = -1; return; }
        if (hipOccupancyMaxActiveBlocksPerMultiprocessor(&per_cu, (const void*)fwd_kernel, 512, LDS_BYTES) != hipSuccess || per_cu < 1) { fprintf(stderr, "kernel_launch: occupancy query says %d blocks per CU\n", per_cu); }
        (void)hipGetLastError();
        grid = cus;
    }
    if (grid < 0) return;
    if (hipMemsetAsync((char*)d_ws + WS_CTL, 0, CTL_ZERO_BYTES, stream) != hipSuccess) return;
    Args a{};
    for (int i = 0; i < 16; ++i) a.in[i] = (const float*)d_in[i];
    a.out = (float*)d_out; a.ws = (unsigned char*)d_ws;
#if MK_PER_PHASE
    for (int ph = 0; ph < NPHASE; ++ph) { a.ph_lo = ph; a.ph_hi = ph + 1; hipLaunchKernelGGL(fwd_kernel, dim3(grid), dim3(512), LDS_BYTES, stream, a); }
#else
    a.ph_lo = 0; a.ph_hi = NPHASE;
    hipLaunchKernelGGL(fwd_kernel, dim3(grid), dim3(512), LDS_BYTES, stream, a);
#endif
}
```

```cpp
#include <hip/hip_runtime.h>
#include <cstdio>
#include <cstdint>

#define LAS __attribute__((address_space(3)))
#define GAS __attribute__((address_space(1)))
typedef unsigned short bf16_t;
typedef short bf16x8 __attribute__((ext_vector_type(8)));
typedef short s16x4 __attribute__((ext_vector_type(4)));
typedef float f32x4 __attribute__((ext_vector_type(4)));
typedef float f32x2 __attribute__((ext_vector_type(2)));
typedef unsigned u32x4 __attribute__((ext_vector_type(4)));
typedef unsigned u32x2 __attribute__((ext_vector_type(2)));
typedef GAS unsigned gu32;

constexpr int BATCH = 8, SEQ = 2048, DM = 2048, MTOK = BATCH * SEQ;
constexpr int POOLW = 1024, NHEAD = 4, DH = 256, CHK = 128, NCHK = SEQ / CHK;
constexpr int FF = 5632, INW = 5120, NMODW = 6 * DM;
constexpr float EPS = 1e-6f;
constexpr int ADA_KC = 16;

constexpr size_t MiB = 1u << 20;
constexpr size_t WS_CTL = 0, CTL_ZERO_BYTES = 65536;
constexpr size_t WS_WIN = 1 * MiB, WS_WO = 21 * MiB, WS_WGU = 29 * MiB, WS_WD = 73 * MiB;
constexpr size_t WS_MODP = 95 * MiB, WS_MOD = 102 * MiB, WS_ROPE = 103 * MiB;
constexpr size_t WS_H = 170 * MiB, WS_CAT = 106 * MiB, WS_PROJ = 234 * MiB, WS_ACT = 234 * MiB, WS_END = 410 * MiB;
constexpr int CW_TMO = 0, CW_BAR = 4096;

constexpr int RING_BYTES = 143360, LDSCTL_OFF = RING_BYTES, LDS_BYTES = 147456;

namespace pg8 {
constexpr int BM = 256, BK = 64, HALF = 128, HTB = HALF * BK * 2, STAGE_BYTES = 8 * HTB, NXCD = 8, WGM = 4;
__host__ __device__ __forceinline__ int lds_byte(int r, int c) { const int st = (r >> 4) * 2 + (c >> 5), rr = r & 15, cc = c & 31, ob = rr * 64 + cc * 2; return st * 1024 + (ob ^ (((ob >> 9) & 1) << 5)); }
__host__ __device__ __forceinline__ void stage_rc(int b, int& R, int& C) { const int st = b / 1024, sb = b % 1024, swz = sb ^ (((sb >> 9) & 1) << 5); R = (st >> 1) * 16 + swz / 64; C = (st & 1) * 32 + (swz % 64) / 2; }
__host__ __device__ __forceinline__ int perm32(int rho) { const int n = rho >> 4, i = rho & 15; return 8 * (i >> 2) + 4 * n + (i & 3); }

struct Unit { int pm, pn; };
struct Gemm { const bf16_t* A; const bf16_t* Bt; int M, N, K; };

struct StaticOrder {
    int nM, nN, nwg, G, c;
    __host__ __device__ void init(int M, int N, int G_, int c_) { nM = M / BM; nN = N / BM; nwg = nM * nN; G = G_; c = c_; }
    __host__ __device__ bool next(int i, Unit& u) const {
        const long L = (long)i * G + c; if (L >= nwg) return false;
        int wgid = (int)L; { const int q = nwg / NXCD, r = nwg % NXCD, xcd = wgid % NXCD, off = wgid / NXCD; wgid = (xcd < r ? xcd * (q + 1) : r * (q + 1) + (xcd - r) * q) + off; }
        const int nig = WGM * nN, gid = wgid / nig, fm = gid * WGM, gsz = (nM - fm) < WGM ? (nM - fm) : WGM;
        u.pm = fm + ((wgid % nig) % gsz); u.pn = (wgid % nig) / gsz; return true;
    }
    __device__ __forceinline__ void a_ready(const Unit&) const {}
    __device__ __forceinline__ void done(const Unit&) const {}
};

__device__ __forceinline__ unsigned cvt_pk_bf16(float lo, float hi) { unsigned r; asm volatile("v_cvt_pk_bf16_f32 %0, %1, %2" : "=v"(r) : "v"(lo), "v"(hi)); return r; }
__device__ __forceinline__ float bflo_(unsigned w) { return __builtin_bit_cast(float, w << 16); }
__device__ __forceinline__ float bfhi_(unsigned w) { return __builtin_bit_cast(float, w & 0xffff0000u); }
__device__ __forceinline__ float fast_silu(float v) { return v * __builtin_amdgcn_rcpf(1.0f + __expf(-v)); }

struct EpiProj {
    static constexpr bool PERM = true, AFTER_DRAIN = false;
    bf16_t* O; const float* cosT; const float* sinT;
    __device__ __forceinline__ void operator()(f32x4 (&acc)[2][2][4][2], const Unit& u, int wr, int wc, int fr, int fq) const {
        const int row0 = u.pm * BM + wr * 64 + fr, col0 = u.pn * BM + wc * 32 + 8 * fq;
        const bool rot = (u.pn >= 4) && (u.pn < 12); const float qs = (u.pn < 8) ? 0.0625f : 1.0f;
        const int jj0 = wc * 32 + 8 * fq;
#pragma unroll
        for (int ai = 0; ai < 2; ++ai)
#pragma unroll
            for (int m = 0; m < 4; ++m) {
                const int row = row0 + ai * HALF + m * 16; bf16_t* rowp = O + (size_t)row * INW + col0;
                f32x4 a0 = acc[ai][0][m][0], a1 = acc[ai][0][m][1], b0 = acc[ai][1][m][0], b1 = acc[ai][1][m][1];
                if (rot) {
                    const int pos = row & (SEQ - 1);
                    const f32x4 c0 = *(const f32x4*)(cosT + pos * 128 + jj0), c1 = *(const f32x4*)(cosT + pos * 128 + jj0 + 4);
                    const f32x4 s0 = *(const f32x4*)(sinT + pos * 128 + jj0), s1 = *(const f32x4*)(sinT + pos * 128 + jj0 + 4);
                    const f32x4 o10 = (a0 * c0 - b0 * s0) * qs, o11 = (a1 * c1 - b1 * s1) * qs;
                    const f32x4 o20 = (a0 * s0 + b0 * c0) * qs, o21 = (a1 * s1 + b1 * c1) * qs;
                    a0 = o10; a1 = o11; b0 = o20; b1 = o21;
                }
                u32x4 w0, w1;
                w0.x = cvt_pk_bf16(a0[0], a0[1]); w0.y = cvt_pk_bf16(a0[2], a0[3]); w0.z = cvt_pk_bf16(a1[0], a1[1]); w0.w = cvt_pk_bf16(a1[2], a1[3]);
                w1.x = cvt_pk_bf16(b0[0], b0[1]); w1.y = cvt_pk_bf16(b0[2], b0[3]); w1.z = cvt_pk_bf16(b1[0], b1[1]); w1.w = cvt_pk_bf16(b1[2], b1[3]);
                *(u32x4*)(rowp) = w0; *(u32x4*)(rowp + HALF) = w1;
            }
    }
};
template <bool BASE_BF16> struct EpiRes {
    static constexpr bool PERM = true, AFTER_DRAIN = false;
    const void* base; bf16_t* out; const float* gv;
    __device__ __forceinline__ void operator()(f32x4 (&acc)[2][2][4][2], const Unit& u, int wr, int wc, int fr, int fq) const {
        const int col0 = u.pn * BM + wc * 32 + 8 * fq; const int b = u.pm >> 3;
        f32x4 g[2][2];
#pragma unroll
        for (int bj = 0; bj < 2; ++bj)
#pragma unroll
            for (int n = 0; n < 2; ++n) g[bj][n] = *(const f32x4*)(gv + (size_t)b * NMODW + col0 + bj * HALF + n * 4);
#pragma unroll
        for (int ai = 0; ai < 2; ++ai) {
            if constexpr (BASE_BF16) {
                u32x4 pre[4][2];
#pragma unroll
                for (int m = 0; m < 4; ++m) { const size_t off = (size_t)(u.pm * BM + ai * HALF + wr * 64 + m * 16 + fr) * DM + col0;
#pragma unroll
                    for (int bj = 0; bj < 2; ++bj) pre[m][bj] = *(const u32x4*)((const bf16_t*)base + off + bj * HALF); }
#pragma unroll
                for (int m = 0; m < 4; ++m) { const size_t off = (size_t)(u.pm * BM + ai * HALF + wr * 64 + m * 16 + fr) * DM + col0;
#pragma unroll
                    for (int bj = 0; bj < 2; ++bj) { const u32x4 p = pre[m][bj]; const f32x4 a0 = acc[ai][bj][m][0] * g[bj][0], a1 = acc[ai][bj][m][1] * g[bj][1];
                        u32x4 w; w.x = cvt_pk_bf16(bflo_(p.x) + a0[0], bfhi_(p.x) + a0[1]); w.y = cvt_pk_bf16(bflo_(p.y) + a0[2], bfhi_(p.y) + a0[3]);
                        w.z = cvt_pk_bf16(bflo_(p.z) + a1[0], bfhi_(p.z) + a1[1]); w.w = cvt_pk_bf16(bflo_(p.w) + a1[2], bfhi_(p.w) + a1[3]);
                        *(u32x4*)(out + off + bj * HALF) = w; } }
            } else {
                f32x4 pre[4][2][2];
#pragma unroll
                for (int m = 0; m < 4; ++m) { const size_t off = (size_t)(u.pm * BM + ai * HALF + wr * 64 + m * 16 + fr) * DM + col0;
#pragma unroll
                    for (int bj = 0; bj < 2; ++bj)
#pragma unroll
                        for (int n = 0; n < 2; ++n) pre[m][bj][n] = *(const f32x4*)((const float*)base + off + bj * HALF + n * 4); }
#pragma unroll
                for (int m = 0; m < 4; ++m) { const size_t off = (size_t)(u.pm * BM + ai * HALF + wr * 64 + m * 16 + fr) * DM + col0;
#pragma unroll
                    for (int bj = 0; bj < 2; ++bj) { const f32x4 v0 = pre[m][bj][0] + acc[ai][bj][m][0] * g[bj][0], v1 = pre[m][bj][1] + acc[ai][bj][m][1] * g[bj][1];
                        u32x4 w; w.x = cvt_pk_bf16(v0[0], v0[1]); w.y = cvt_pk_bf16(v0[2], v0[3]); w.z = cvt_pk_bf16(v1[0], v1[1]); w.w = cvt_pk_bf16(v1[2], v1[3]);
                        *(u32x4*)(out + off + bj * HALF) = w; } }
            }
            asm volatile("" ::: "memory");
        }
    }
};
struct EpiSwiGLU {
    static constexpr bool PERM = true, AFTER_DRAIN = false;
    bf16_t* O;
    __device__ __forceinline__ void operator()(f32x4 (&acc)[2][2][4][2], const Unit& u, int wr, int wc, int fr, int fq) const {
        const int row0 = u.pm * BM + wr * 64 + fr, col0 = u.pn * HALF + wc * 32 + 8 * fq;
#pragma unroll
        for (int ai = 0; ai < 2; ++ai)
#pragma unroll
            for (int m = 0; m < 4; ++m) {
                bf16_t* rowp = O + (size_t)(row0 + ai * HALF + m * 16) * FF + col0;
                const f32x4 g0 = acc[ai][0][m][0], g1 = acc[ai][0][m][1], u0 = acc[ai][1][m][0], u1 = acc[ai][1][m][1];
                f32x4 o0, o1;
#pragma unroll
                for (int e = 0; e < 4; ++e) { o0[e] = fast_silu(g0[e]) * u0[e]; o1[e] = fast_silu(g1[e]) * u1[e]; }
                u32x4 w; w.x = cvt_pk_bf16(o0[0], o0[1]); w.y = cvt_pk_bf16(o0[2], o0[3]); w.z = cvt_pk_bf16(o1[0], o1[1]); w.w = cvt_pk_bf16(o1[2], o1[3]);
                *(u32x4*)rowp = w;
            }
    }
};

template <class Epi, class Sched, bool ALIGN_EPI = false, bool SP2 = false>
__device__ __forceinline__ void gemm_phase(LAS unsigned char* lds, const Gemm g, const Sched& S, const Epi& E) {
    int tid = threadIdx.x; asm volatile("" : "+v"(tid));
    const int wid = __builtin_amdgcn_readfirstlane(tid >> 6), lane = tid & 63, wr = wid >> 2, wc = wid & 3, fr = lane & 15, fq = lane >> 4;
    const int K = g.K, nt = K / BK;
    unsigned voffA[2], voffB[2];
#pragma unroll
    for (int i = 0; i < 2; ++i) { int R, C; stage_rc(tid * 16 + i * 8192, R, C); const int Rb = Epi::PERM ? ((R & ~31) + perm32(R & 31)) : R;
        voffA[i] = (unsigned)(R * K + C) * 2u; voffB[i] = (unsigned)(Rb * K + C) * 2u; }
    const size_t kstep = (size_t)(BK * 2);
    const size_t hstep = (size_t)HALF * K * 2;
    const size_t tstep = 2 * hstep;
    const unsigned ldsw = (unsigned)wid * 1024u;
    const int aoff = lds_byte(wr * 64 + fr, fq * 8), boff = lds_byte(wc * 32 + fr, fq * 8);
#define PG8_SA(b, h) (((b) * 2 + (h)) * HTB)
#define PG8_SB(b, h) ((4 + (b) * 2 + (h)) * HTB)
#define PG8_STAGE(bufoff, gbase, voff) do { _Pragma("unroll") for (int _i = 0; _i < 2; ++_i) \
        __builtin_amdgcn_global_load_lds((const unsigned*)((const char*)(gbase) + (voff)[_i]), (LAS unsigned*)(lds + (bufoff) + ldsw + _i * 8192), 16, 0, 0); } while (0)
#define PG8_LDA(dst, b, h) do { _Pragma("unroll") for (int m = 0; m < 4; ++m) _Pragma("unroll") for (int k = 0; k < 2; ++k) dst[m][k] = *(const LAS bf16x8*)(lds + PG8_SA(b, h) + aoff + m * 2048 + k * 1024); } while (0)
#define PG8_LDB(dst, b, h) do { _Pragma("unroll") for (int n = 0; n < 2; ++n) _Pragma("unroll") for (int k = 0; k < 2; ++k) dst[n][k] = *(const LAS bf16x8*)(lds + PG8_SB(b, h) + boff + n * 2048 + k * 1024); } while (0)
#define PG8_MMA(ai, bj, At, Bt) do { __builtin_amdgcn_s_setprio(1); _Pragma("unroll") for (int k = 0; k < 2; ++k) _Pragma("unroll") for (int m = 0; m < 4; ++m) _Pragma("unroll") for (int n = 0; n < 2; ++n) \
        acc[ai][bj][m][n] = __builtin_amdgcn_mfma_f32_16x16x32_bf16(Bt[n][k], At[m][k], acc[ai][bj][m][n], 0, 0, 0); __builtin_amdgcn_s_setprio(0); } while (0)
#define PG8_WAIT_V(n) asm volatile("s_waitcnt vmcnt(" #n ")" ::: "memory")
#define PG8_WAIT_L(n) asm volatile("s_waitcnt lgkmcnt(" #n ")" ::: "memory")
#define PG8_BAR __builtin_amdgcn_s_barrier()
#define PG8_SCHED __builtin_amdgcn_sched_barrier(0)
    Unit cur, nxt; int ui = 0;
    if (!S.next(0, cur)) return;
    f32x4 acc[2][2][4][2];
#pragma unroll
    for (int a = 0; a < 2; ++a)
#pragma unroll
        for (int b = 0; b < 2; ++b)
#pragma unroll
            for (int m = 0; m < 4; ++m)
#pragma unroll
                for (int n = 0; n < 2; ++n) acc[a][b][m][n] = (f32x4){0.f, 0.f, 0.f, 0.f};
    bf16x8 At[4][2], B0[2][2], B1[2][2];
    const char* cA = (const char*)g.A + (size_t)cur.pm * tstep; const char* cB = (const char*)g.Bt + (size_t)cur.pn * tstep;
    S.a_ready(cur);
    if constexpr (SP2) {
        PG8_STAGE(PG8_SB(0, 0), cB, voffB); PG8_STAGE(PG8_SB(0, 1), cB + hstep, voffB); PG8_STAGE(PG8_SA(0, 0), cA, voffA); PG8_STAGE(PG8_SA(0, 1), cA + hstep, voffA);
        if (wr == 1) PG8_BAR;
        PG8_WAIT_V(2); PG8_BAR;
        PG8_STAGE(PG8_SB(1, 0), cB + kstep, voffB); PG8_STAGE(PG8_SA(1, 0), cA + kstep, voffA); PG8_STAGE(PG8_SB(1, 1), cB + hstep + kstep, voffB);
        PG8_WAIT_V(6); PG8_BAR;
    } else {
        PG8_STAGE(PG8_SB(0, 0), cB, voffB); PG8_STAGE(PG8_SA(0, 0), cA, voffA); PG8_STAGE(PG8_SB(0, 1), cB + hstep, voffB); PG8_STAGE(PG8_SA(0, 1), cA + hstep, voffA);
        if (wr == 1) PG8_BAR;
        PG8_WAIT_V(4); PG8_BAR;
        PG8_STAGE(PG8_SB(1, 0), cB + kstep, voffB); PG8_STAGE(PG8_SA(1, 0), cA + kstep, voffA); PG8_STAGE(PG8_SB(1, 1), cB + hstep + kstep, voffB);
        PG8_WAIT_V(6); PG8_BAR;
    }
    for (;;) {
        const bool has_next = S.next(ui + 1, nxt);
        const char* nA = has_next ? (const char*)g.A + (size_t)nxt.pm * tstep : cA; const char* nB = has_next ? (const char*)g.Bt + (size_t)nxt.pn * tstep : cB;
        for (int t = 0; t < nt; t += 2) {
            const bool last = (t == nt - 2);
            const char* a1 = cA + (size_t)(t + 1) * kstep;
            const char* a2 = last ? nA : cA + (size_t)(t + 2) * kstep; const char* b2 = last ? nB : cB + (size_t)(t + 2) * kstep;
            const char* a3 = a2 + kstep; const char* b3 = b2 + kstep;
            if (last && has_next) S.a_ready(nxt);
            if constexpr (SP2) {
            PG8_LDB(B0, 0, 0); PG8_LDB(B1, 0, 1); PG8_SCHED; PG8_LDA(At, 0, 0); PG8_STAGE(PG8_SA(1, 1), a1 + hstep, voffA);
            PG8_WAIT_V(8); PG8_WAIT_L(0); PG8_BAR; PG8_MMA(0, 0, At, B0); PG8_MMA(0, 1, At, B1); PG8_BAR; PG8_SCHED;
            PG8_LDA(At, 0, 1); PG8_STAGE(PG8_SB(0, 0), b2, voffB); PG8_STAGE(PG8_SB(0, 1), b2 + hstep, voffB); PG8_STAGE(PG8_SA(0, 0), a2, voffA);
            PG8_WAIT_V(8); PG8_WAIT_L(0); PG8_BAR; PG8_MMA(1, 0, At, B0); PG8_MMA(1, 1, At, B1); PG8_BAR; PG8_SCHED;
            PG8_LDB(B0, 1, 0); PG8_LDB(B1, 1, 1); PG8_SCHED; PG8_LDA(At, 1, 0); PG8_STAGE(PG8_SA(0, 1), a2 + hstep, voffA);
            PG8_WAIT_V(8); PG8_WAIT_L(0); PG8_BAR; PG8_MMA(0, 0, At, B0); PG8_MMA(0, 1, At, B1); PG8_BAR; PG8_SCHED;
            PG8_LDA(At, 1, 1); PG8_STAGE(PG8_SB(1, 0), b3, voffB); PG8_STAGE(PG8_SB(1, 1), b3 + hstep, voffB); PG8_STAGE(PG8_SA(1, 0), a3, voffA);
            PG8_WAIT_V(8); PG8_WAIT_L(0); PG8_BAR; PG8_MMA(1, 0, At, B0); PG8_MMA(1, 1, At, B1); PG8_BAR; PG8_SCHED;
            } else {
            PG8_LDB(B0, 0, 0); PG8_SCHED; PG8_LDA(At, 0, 0); PG8_STAGE(PG8_SA(1, 1), a1 + hstep, voffA);
            PG8_WAIT_L(8); PG8_BAR; PG8_WAIT_L(0); PG8_MMA(0, 0, At, B0); PG8_BAR; PG8_SCHED;
            PG8_LDB(B1, 0, 1); PG8_STAGE(PG8_SB(0, 0), b2, voffB);
            PG8_BAR; PG8_WAIT_L(0); PG8_MMA(0, 1, At, B1); PG8_BAR;
            PG8_LDA(At, 0, 1); PG8_STAGE(PG8_SA(0, 0), a2, voffA);
            PG8_BAR; PG8_WAIT_L(0); PG8_MMA(1, 0, At, B0); PG8_BAR; PG8_SCHED;
            PG8_STAGE(PG8_SB(0, 1), b2 + hstep, voffB);
            PG8_WAIT_V(6); PG8_BAR; PG8_MMA(1, 1, At, B1); PG8_BAR;
            PG8_LDB(B0, 1, 0); PG8_SCHED; PG8_LDA(At, 1, 0); PG8_STAGE(PG8_SA(0, 1), a2 + hstep, voffA);
            PG8_WAIT_L(8); PG8_BAR; PG8_WAIT_L(0); PG8_MMA(0, 0, At, B0); PG8_BAR; PG8_SCHED;
            PG8_LDB(B1, 1, 1); PG8_STAGE(PG8_SB(1, 0), b3, voffB);
            PG8_BAR; PG8_WAIT_L(0); PG8_MMA(0, 1, At, B1); PG8_BAR;
            PG8_LDA(At, 1, 1); PG8_STAGE(PG8_SA(1, 0), a3, voffA);
            PG8_BAR; PG8_WAIT_L(0); PG8_MMA(1, 0, At, B0); PG8_BAR; PG8_SCHED;
            PG8_STAGE(PG8_SB(1, 1), b3 + hstep, voffB);
            PG8_WAIT_V(6); PG8_BAR; PG8_MMA(1, 1, At, B1); PG8_BAR;
            }
        }
        if constexpr (ALIGN_EPI) { if (wr == 0) PG8_BAR; }
        if constexpr (!Epi::AFTER_DRAIN) { E(acc, cur, wr, wc, fr, fq); S.done(cur); }
        if (!has_next) break;
#pragma unroll
        for (int a = 0; a < 2; ++a)
#pragma unroll
            for (int b = 0; b < 2; ++b)
#pragma unroll
                for (int m = 0; m < 4; ++m)
#pragma unroll
                    for (int n = 0; n < 2; ++n) acc[a][b][m][n] = (f32x4){0.f, 0.f, 0.f, 0.f};
        cur = nxt; cA = nA; cB = nB; ++ui;
        if constexpr (ALIGN_EPI) { if (wr == 1) PG8_BAR; }
    }
    PG8_WAIT_V(0);
    if constexpr (!ALIGN_EPI) { if (wr == 0) PG8_BAR; }
    PG8_BAR;
#undef PG8_SA
#undef PG8_SB
#undef PG8_STAGE
#undef PG8_LDA
#undef PG8_LDB
#undef PG8_MMA
#undef PG8_WAIT_V
#undef PG8_WAIT_L
#undef PG8_BAR
#undef PG8_SCHED
}
}

#define RLX_AGENT __ATOMIC_RELAXED, __HIP_MEMORY_SCOPE_AGENT
#define LDS_WAIT() asm volatile("s_waitcnt lgkmcnt(0)" ::: "memory")
__device__ __forceinline__ unsigned f2bf(float f) { unsigned u = __builtin_bit_cast(unsigned, f); return (u + 0x7fffu + ((u >> 16) & 1u)) >> 16; }
__device__ __forceinline__ unsigned pk2(float lo, float hi) { return f2bf(lo) | (f2bf(hi) << 16); }
__device__ __forceinline__ float bflo(unsigned w) { return __builtin_bit_cast(float, w << 16); }
__device__ __forceinline__ float bfhi(unsigned w) { return __builtin_bit_cast(float, w & 0xffff0000u); }
__device__ __forceinline__ float ex2(float x) { return __builtin_amdgcn_exp2f(x); }
__device__ __forceinline__ float wave_sum(float v) {
#pragma unroll
    for (int o = 1; o < 64; o <<= 1) v += __shfl_xor(v, o);
    return v;
}

#define XB_TMO      128
#define XB_XCNT(j)  (256  + 64 * (j))
#define XB_XSUB(j)  (1280 + 64 * (j))
#define XB_XGEN(j)  (2304 + 64 * (j))
#define XB_TOP      3328
#define XB_TOPGEN   3392
#define XCD_BAR_WORDS 3456
#define XB_SPIN_CAP (1u << 18)
__device__ __forceinline__ unsigned xb_ld(unsigned* p)              { return __hip_atomic_load(p, __ATOMIC_RELAXED, __HIP_MEMORY_SCOPE_AGENT); }
__device__ __forceinline__ unsigned xb_add(unsigned* p, unsigned v) { return __hip_atomic_fetch_add(p, v, __ATOMIC_RELAXED, __HIP_MEMORY_SCOPE_AGENT); }
__device__ __forceinline__ unsigned xb_xcc_id() { return (unsigned)__builtin_amdgcn_s_getreg((3 << 11) | 20) & 0xFu; }
#define XB_SPIN(cond, bar) do { unsigned _sp = 0; while (cond) { __builtin_amdgcn_s_sleep(1); \
    if ((++_sp & 255u) == 0u) { if (xb_ld(&(bar)[XB_TMO])) break; if (_sp > XB_SPIN_CAP) { atomicAdd(&(bar)[XB_TMO], 1u); break; } } } } while (0)
struct XcdBarrier { unsigned* bar; unsigned x; volatile LAS unsigned* st; };
__device__ __forceinline__ XcdBarrier xcd_barrier_post(unsigned* bar, volatile LAS unsigned* st) {
    XcdBarrier b; b.bar = bar; b.x = xb_xcc_id(); b.st = st;
    if (threadIdx.x == 0) (void)xb_add(&bar[XB_XCNT(b.x)], 1u);
    return b;
}
__device__ __forceinline__ void xcd_barrier_complete(unsigned* bar, unsigned x, unsigned& nloc, unsigned& nx) {
    const unsigned G = gridDim.x * gridDim.y * gridDim.z;
    unsigned sum, cnt, mine, sp = 0u;
    for (;;) {
        sum = 0u; cnt = 0u; mine = 0u;
#pragma unroll
        for (unsigned j = 0; j < 16; ++j) { const unsigned c = xb_ld(&bar[XB_XCNT(j)]); sum += c; cnt += (c > 0u) ? 1u : 0u; mine = (j == x) ? c : mine; }
        if (sum == G) break;
        __builtin_amdgcn_s_sleep(1);
        if ((++sp & 255u) == 0u) { if (xb_ld(&bar[XB_TMO])) break; if (sp > XB_SPIN_CAP) { atomicAdd(&bar[XB_TMO], 1u); break; } }
    }
    nloc = mine > 0u ? mine : 1u; nx = cnt > 0u ? cnt : 1u;
}
__device__ __forceinline__ void xcd_barrier(const XcdBarrier& b) {
    asm volatile("s_waitcnt vmcnt(0)" ::: "memory");
    __syncthreads();
    if (threadIdx.x == 0) {
        unsigned* bar = b.bar;
        __builtin_amdgcn_s_waitcnt(0);
        unsigned nloc = b.st[0], nx = b.st[1];
        if (nloc == 0u) { xcd_barrier_complete(bar, b.x, nloc, nx); b.st[0] = nloc; b.st[1] = nx; }
        const unsigned old = xb_add(&bar[XB_XSUB(b.x)], 1u);
        const unsigned gen = old / nloc;
        if (old + 1u == (gen + 1u) * nloc) {
            __builtin_amdgcn_fence(__ATOMIC_RELEASE, "agent");
            asm volatile("s_waitcnt vmcnt(0)" ::: "memory");
            const unsigned og = xb_add(&bar[XB_TOP], 1u);
            const unsigned tg = og / nx;
            if (og + 1u == (tg + 1u) * nx) xb_add(&bar[XB_TOPGEN], 1u);
            else XB_SPIN(xb_ld(&bar[XB_TOPGEN]) == tg, bar);
            __builtin_amdgcn_fence(__ATOMIC_ACQUIRE, "agent");
            xb_add(&bar[XB_XGEN(b.x)], 1u);
            asm volatile("s_waitcnt vmcnt(0)" ::: "memory");
        } else {
            XB_SPIN(xb_ld(&bar[XB_XGEN(b.x)]) == gen, bar);
            __builtin_amdgcn_fence(__ATOMIC_ACQUIRE, "agent");
            asm volatile("s_waitcnt vmcnt(0)" ::: "memory");
        }
    }
    __syncthreads();
}

struct Ctx { LAS unsigned char* lds; int tid, lane, wave, vcu, G; };

__host__ __device__ __forceinline__ int perm5(int n) { return 8 * ((n >> 2) & 3) + 4 * ((n >> 4) & 1) + (n & 3); }
template <bool PERMN, bool PERMK>
__device__ __forceinline__ void p0_transpose_item(const float* W, int ldw, bf16_t* WT, int kdst, int k0, int n_src0, int drow0, LAS float* scr, int lane) {
#pragma unroll 8
    for (int i = 0; i < 32; ++i) { const int kk = 2 * i + (lane >> 5); scr[kk * 33 + (lane & 31)] = __builtin_nontemporal_load(W + (size_t)(k0 + kk) * ldw + n_src0 + (lane & 31)); }
    LDS_WAIT(); asm volatile("" ::: "memory");
    const int c = lane & 7;
#pragma unroll
    for (int j = 0; j < 4; ++j) { const int n = (lane >> 3) + 8 * j;
        float v[8];
#pragma unroll
        for (int e = 0; e < 8; ++e) { const int kk = PERMK ? (32 * (c >> 2) + 16 * (e >> 2) + 4 * (c & 3) + (e & 3)) : (8 * c + e); v[e] = scr[kk * 33 + n]; }
        u32x4 o; o.x = pk2(v[0], v[1]); o.y = pk2(v[2], v[3]); o.z = pk2(v[4], v[5]); o.w = pk2(v[6], v[7]);
        *(GAS u32x4*)(WT + (size_t)(drow0 + (PERMN ? perm5(n) : n)) * kdst + k0 + 8 * c) = o; }
    LDS_WAIT(); asm volatile("" ::: "memory");
}

struct P0Args { const float *c, *w_ada, *w_in, *pool_w, *pool_scale, *w_out, *w_gate, *w_up, *w_down; bf16_t *WinT, *WoT, *WguT, *WdT; float *modp, *cosT, *sinT; };

__device__ __forceinline__ void p0_prologue(const Ctx& F, const P0Args& A) {
    const int tid = F.tid, lane = F.lane, w = F.wave;
    {
        LAS float* cact = (LAS float*)(F.lds);
        LAS float* red = (LAS float*)(F.lds + 12288);
        constexpr int NIT = 48 * ADA_KC;
        f32x4 wv[16], wvn[16];
        if (F.vcu < NIT) { const int cg = F.vcu % 48, kc = F.vcu / 48; const float* wp = A.w_ada + (size_t)(kc * 128 + w * 16) * NMODW + cg * 256 + lane * 4;
#pragma unroll
            for (int r = 0; r < 16; ++r) wv[r] = __builtin_nontemporal_load((const f32x4*)(wp + (size_t)r * NMODW)); }
        { int slot = 0;
          for (int it = F.vcu; it < NIT && slot < 3; it += F.G, ++slot) { const int kc = it / 48;
              for (int i = tid; i < 1024; i += 512) { const int kk = i >> 3, bb = i & 7; const float cv = A.c[bb * DM + kc * 128 + kk]; cact[slot * 1024 + kk * 8 + bb] = cv / (1.0f + __expf(-cv)); } } }
        __syncthreads();
        int slot = 0;
        for (int it = F.vcu; it < NIT; it += F.G, ++slot) {
            const int cg = it % 48, kc = it / 48;
            if (it + F.G < NIT) { const int itn = it + F.G, cgn = itn % 48, kcn = itn / 48; const float* wp = A.w_ada + (size_t)(kcn * 128 + w * 16) * NMODW + cgn * 256 + lane * 4;
#pragma unroll
                for (int r = 0; r < 16; ++r) wvn[r] = __builtin_nontemporal_load((const f32x4*)(wp + (size_t)r * NMODW)); }
            f32x4 acc[8];
#pragma unroll
            for (int bb = 0; bb < 8; ++bb) acc[bb] = (f32x4){0.f, 0.f, 0.f, 0.f};
            const LAS float* ca_ = cact + (slot % 3) * 1024;
#pragma unroll
            for (int r = 0; r < 16; ++r) {
                const f32x4 ca = *(const LAS f32x4*)(ca_ + (w * 16 + r) * 8), cb = *(const LAS f32x4*)(ca_ + (w * 16 + r) * 8 + 4);
                acc[0] += ca[0] * wv[r]; acc[1] += ca[1] * wv[r]; acc[2] += ca[2] * wv[r]; acc[3] += ca[3] * wv[r];
                acc[4] += cb[0] * wv[r]; acc[5] += cb[1] * wv[r]; acc[6] += cb[2] * wv[r]; acc[7] += cb[3] * wv[r];
            }
#pragma unroll
            for (int bb = 0; bb < 8; ++bb) *(LAS f32x4*)(red + (w * 8 + bb) * 256 + lane * 4) = acc[bb];
            __syncthreads();
            { const int bb = tid >> 6, col = (tid & 63) * 4; f32x4 sm = (f32x4){0.f, 0.f, 0.f, 0.f};
#pragma unroll
              for (int ww = 0; ww < 8; ++ww) sm += *(const LAS f32x4*)(red + (ww * 8 + bb) * 256 + col);
              *(f32x4*)(A.modp + (size_t)(kc * 8 + bb) * NMODW + cg * 256 + col) = sm; }
            __syncthreads();
#pragma unroll
            for (int r = 0; r < 16; ++r) wv[r] = wvn[r];
        }
    }
    {
        const int fr = lane & 15, g4 = lane >> 4;
        for (int u = F.vcu; u < 256; u += F.G) {
            const int g = u >> 6, k0 = (u & 63) * 32;
            f32x4 acc[2][2];
#pragma unroll
            for (int kt = 0; kt < 2; ++kt)
#pragma unroll
                for (int nt = 0; nt < 2; ++nt) acc[kt][nt] = (f32x4){0.f, 0.f, 0.f, 0.f};
            const float* ap = A.w_in + (size_t)(k0 + fr) * INW + g * 256 + 8 * g4;
            const float* bp = A.pool_w + (size_t)(g * 256 + 8 * g4) * 256 + 32 * w + fr;
#pragma unroll 2
            for (int s = 0; s < 8; ++s) {
                bf16x8 af[2], bq[2];
#pragma unroll
                for (int kt = 0; kt < 2; ++kt) { const f32x4 a0 = *(const f32x4*)(ap + (size_t)(16 * kt) * INW + 32 * s), a1 = *(const f32x4*)(ap + (size_t)(16 * kt) * INW + 32 * s + 4);
                    u32x4 t; t.x = pk2(a0[0], a0[1]); t.y = pk2(a0[2], a0[3]); t.z = pk2(a1[0], a1[1]); t.w = pk2(a1[2], a1[3]); af[kt] = __builtin_bit_cast(bf16x8, t); }
#pragma unroll
                for (int nt = 0; nt < 2; ++nt) { float bv[8];
#pragma unroll
                    for (int e = 0; e < 8; ++e) bv[e] = bp[(size_t)(32 * s + e) * 256 + 16 * nt];
                    u32x4 t; t.x = pk2(bv[0], bv[1]); t.y = pk2(bv[2], bv[3]); t.z = pk2(bv[4], bv[5]); t.w = pk2(bv[6], bv[7]); bq[nt] = __builtin_bit_cast(bf16x8, t); }
#pragma unroll
                for (int kt = 0; kt < 2; ++kt)
#pragma unroll
                    for (int nt = 0; nt < 2; ++nt) acc[kt][nt] = __builtin_amdgcn_mfma_f32_16x16x32_bf16(af[kt], bq[nt], acc[kt][nt], 0, 0, 0);
            }
#pragma unroll
            for (int nt = 0; nt < 2; ++nt) { const int n = 32 * w + 16 * nt + fr; const float sc = A.pool_scale[g * 256 + n];
#pragma unroll
                for (int kt = 0; kt < 2; ++kt) { u32x2 o; o.x = pk2(acc[kt][nt][0] * sc, acc[kt][nt][1] * sc); o.y = pk2(acc[kt][nt][2] * sc, acc[kt][nt][3] * sc);
                    *(GAS u32x2*)(A.WinT + (size_t)(g * 256 + n) * DM + k0 + 16 * kt + 4 * g4) = o; } }
        }
    }
    for (int idx = F.vcu * 512 + tid; idx < SEQ * 128; idx += F.G * 512) {
        const int pos = idx >> 7, j = idx & 127;
        const float t = (float)j / 127.0f;
        const float inv = ex2(-t * 13.287712379549449f);
        const double ang = (double)((float)pos * inv);
        const double kq = __builtin_rint(ang * 0.63661977236758134308);
        const double r = (ang - kq * 1.57079632679489655800) - kq * 6.12323399573676603587e-17;
        const double r2 = r * r;
        const double sn = r * (1.0 + r2 * (-1.0 / 6 + r2 * (1.0 / 120 + r2 * (-1.0 / 5040 + r2 * (1.0 / 362880 + r2 * (-1.0 / 39916800 + r2 * (1.0 / 6227020800.0)))))));
        const double cs = 1.0 + r2 * (-0.5 + r2 * (1.0 / 24 + r2 * (-1.0 / 720 + r2 * (1.0 / 40320 + r2 * (-1.0 / 3628800 + r2 * (1.0 / 479001600.0 + r2 * (-1.0 / 87178291200.0)))))));
        const int qd = ((int)kq) & 3;
        const double c = (qd == 0) ? cs : (qd == 1) ? -sn : (qd == 2) ? -cs : sn;
        const double s = (qd == 0) ? sn : (qd == 1) ? cs : (qd == 2) ? -sn : -cs;
        A.cosT[idx] = (float)c; A.sinT[idx] = (float)s;
    }
    {
        LAS float* scr = (LAS float*)(F.lds + w * 16384);
        const int gw = F.vcu * 8 + w, NGW = F.G * 8;
        constexpr int I_IN = (DM / 64) * ((INW - POOLW) / 32), I_O = (DM / 64) * (DM / 32), I_G = (DM / 64) * (FF / 32), I_D = (FF / 64) * (DM / 32);
        constexpr int NITEMS = I_IN + I_O + 2 * I_G + I_D;
        for (int it = gw; it < NITEMS; it += NGW) {
            int r = it;
            if (r < I_IN) { const int nblk = (INW - POOLW) / 32, kb = r / nblk, nb = r % nblk; if (nb >= 96) p0_transpose_item<true, false>(A.w_in + POOLW, INW, A.WinT, DM, kb * 64, nb * 32, POOLW + nb * 32, scr, lane); else p0_transpose_item<false, false>(A.w_in + POOLW, INW, A.WinT, DM, kb * 64, nb * 32, POOLW + nb * 32, scr, lane); continue; } r -= I_IN;
            if (r < I_O) { const int nblk = DM / 32, kb = r / nblk, nb = r % nblk; if (kb >= 16) p0_transpose_item<false, true>(A.w_out, DM, A.WoT, DM, kb * 64, nb * 32, nb * 32, scr, lane); else p0_transpose_item<false, false>(A.w_out, DM, A.WoT, DM, kb * 64, nb * 32, nb * 32, scr, lane); continue; } r -= I_O;
            if (r < I_G) { const int nblk = FF / 32, kb = r / nblk, nb = r % nblk; p0_transpose_item<false, false>(A.w_gate, FF, A.WguT, DM, kb * 64, nb * 32, 256 * (nb >> 2) + 32 * (nb & 3), scr, lane); continue; } r -= I_G;
            if (r < I_G) { const int nblk = FF / 32, kb = r / nblk, nb = r % nblk; p0_transpose_item<false, false>(A.w_up, FF, A.WguT, DM, kb * 64, nb * 32, 256 * (nb >> 2) + 128 + 32 * (nb & 3), scr, lane); continue; } r -= I_G;
            { const int nblk = DM / 32, kb = r / nblk, nb = r % nblk; p0_transpose_item<false, false>(A.w_down, DM, A.WdT, FF, kb * 64, nb * 32, nb * 32, scr, lane); }
        }
    }
}

template <int MODE>
__device__ __forceinline__ void norm_mod_phase(const Ctx& F, const float* src, bf16_t* dst, const float* gnorm, const float* modp, const float* b_ada, float* mod, int sh_idx, int sc_idx) {
    LAS float* Av = (LAS float*)(F.lds); LAS float* Bv = (LAS float*)(F.lds + 8192);
    for (int blk = F.vcu; blk < MTOK / 64; blk += F.G) {
        const int b = blk >> 5;
        const int row0 = blk * 64 + F.wave * 8;
        f32x4 v[8], vn[8];
        { const GAS f32x4* xr = (const GAS f32x4*)(src + (size_t)row0 * DM) + F.lane;
#pragma unroll
          for (int j = 0; j < 8; ++j) v[j] = __builtin_nontemporal_load(xr + 64 * j); }
        __syncthreads();
        for (int k = F.tid; k < DM; k += 512) {
            float sc, sh;
            if (MODE == 0) {
                sc = b_ada[sc_idx * DM + k]; sh = b_ada[sh_idx * DM + k];
#pragma unroll 4
                for (int kc = 0; kc < ADA_KC; ++kc) { sc += modp[(size_t)(kc * 8 + b) * NMODW + sc_idx * DM + k]; sh += modp[(size_t)(kc * 8 + b) * NMODW + sh_idx * DM + k]; }
            } else { sc = mod[(size_t)b * NMODW + sc_idx * DM + k]; sh = mod[(size_t)b * NMODW + sh_idx * DM + k]; }
            Av[k] = gnorm[k] * (1.0f + sc); Bv[k] = sh;
        }
        if (MODE == 0) {
            if (F.tid < 384) { const int idx = blk * 384 + F.tid, bb = idx / NMODW, n = idx % NMODW; float s = b_ada[n];
#pragma unroll 4
                for (int kc = 0; kc < ADA_KC; ++kc) s += modp[(size_t)(kc * 8 + bb) * NMODW + n];
                mod[idx] = s; }
        }
        __syncthreads();
        {
            for (int i = 0; i < 8; ++i) {
                const int row = row0 + i;
                if (i < 7) { const GAS f32x4* xr = (const GAS f32x4*)(src + (size_t)(row + 1) * DM) + F.lane;
#pragma unroll
                    for (int j = 0; j < 8; ++j) vn[j] = __builtin_nontemporal_load(xr + 64 * j); }
                float s = 0.f;
#pragma unroll
                for (int j = 0; j < 8; ++j) s += (v[j][0] * v[j][0] + v[j][1] * v[j][1]) + (v[j][2] * v[j][2] + v[j][3] * v[j][3]);
                const float rstd = 1.0f / sqrtf(wave_sum(s) * (1.0f / DM) + EPS);
                GAS u32x2* o8 = (GAS u32x2*)(dst + (size_t)row * DM) + F.lane;
#pragma unroll
                for (int j = 0; j < 8; ++j) { const f32x4 a = *(const LAS f32x4*)(Av + 4 * F.lane + 256 * j), bb = *(const LAS f32x4*)(Bv + 4 * F.lane + 256 * j);
                    const f32x4 o = v[j] * rstd * a + bb; u32x2 wv; wv.x = pk2(o[0], o[1]); wv.y = pk2(o[2], o[3]); o8[64 * j] = wv; }
#pragma unroll
                for (int j = 0; j < 8; ++j) v[j] = vn[j];
            }
        }
    }
}

__device__ __forceinline__ void norm_mod_bf16_phase(const Ctx& F, const bf16_t* src, bf16_t* dst, const float* gnorm, const float* mod, int sh_idx, int sc_idx) {
    LAS float* Av = (LAS float*)(F.lds); LAS float* Bv = (LAS float*)(F.lds + 8192);
    for (int blk = F.vcu; blk < MTOK / 64; blk += F.G) {
        const int b = blk >> 5;
        __syncthreads();
        for (int k = F.tid; k < DM; k += 512) { const float sc = mod[(size_t)b * NMODW + sc_idx * DM + k], sh = mod[(size_t)b * NMODW + sh_idx * DM + k]; Av[k] = gnorm[k] * (1.0f + sc); Bv[k] = sh; }
        __syncthreads();
        const int row0 = blk * 64 + F.wave * 8;
        u32x4 v[4], vn[4];
        { const GAS u32x4* xr = (const GAS u32x4*)(src + (size_t)row0 * DM) + F.lane;
#pragma unroll
          for (int j = 0; j < 4; ++j) v[j] = xr[64 * j]; }
        for (int i = 0; i < 8; ++i) {
            const int row = row0 + i;
            if (i < 7) { const GAS u32x4* xr = (const GAS u32x4*)(src + (size_t)(row + 1) * DM) + F.lane;
#pragma unroll
                for (int j = 0; j < 4; ++j) vn[j] = xr[64 * j]; }
            float f[4][8]; float s = 0.f;
#pragma unroll
            for (int j = 0; j < 4; ++j) { f[j][0] = bflo(v[j].x); f[j][1] = bfhi(v[j].x); f[j][2] = bflo(v[j].y); f[j][3] = bfhi(v[j].y); f[j][4] = bflo(v[j].z); f[j][5] = bfhi(v[j].z); f[j][6] = bflo(v[j].w); f[j][7] = bfhi(v[j].w);
#pragma unroll
                for (int e = 0; e < 8; ++e) s += f[j][e] * f[j][e]; }
            const float rstd = 1.0f / sqrtf(wave_sum(s) * (1.0f / DM) + EPS);
            GAS u32x4* o16 = (GAS u32x4*)(dst + (size_t)row * DM) + F.lane;
#pragma unroll
            for (int j = 0; j < 4; ++j) { const LAS float* ap = Av + 8 * F.lane + 512 * j; const LAS float* bp = Bv + 8 * F.lane + 512 * j;
                const f32x4 a0 = *(const LAS f32x4*)ap, a1 = *(const LAS f32x4*)(ap + 4), b0 = *(const LAS f32x4*)bp, b1 = *(const LAS f32x4*)(bp + 4);
                u32x4 w; w.x = pk2(f[j][0] * rstd * a0[0] + b0[0], f[j][1] * rstd * a0[1] + b0[1]); w.y = pk2(f[j][2] * rstd * a0[2] + b0[2], f[j][3] * rstd * a0[3] + b0[3]);
                w.z = pk2(f[j][4] * rstd * a1[0] + b1[0], f[j][5] * rstd * a1[1] + b1[1]); w.w = pk2(f[j][6] * rstd * a1[2] + b1[2], f[j][7] * rstd * a1[3] + b1[3]);
                o16[64 * j] = w; }
#pragma unroll
            for (int j = 0; j < 4; ++j) v[j] = vn[j];
        }
    }
}

__device__ __forceinline__ void final_norm_phase(const Ctx& F, const bf16_t* src, float* out, const float* g) {
    const int gw = F.vcu * 8 + F.wave, NGW = F.G * 8;
    static_assert(MTOK % 2048 == 0, "rows per wave");
    for (int r0 = gw; r0 < MTOK; r0 += NGW * 8) {
        u32x4 v[8][4];
#pragma unroll
        for (int i = 0; i < 8; ++i) { const GAS u32x4* xr = (const GAS u32x4*)(src + (size_t)(r0 + i * NGW) * DM) + F.lane;
#pragma unroll
            for (int j = 0; j < 4; ++j) v[i][j] = (r0 + i * NGW < MTOK) ? xr[64 * j] : (u32x4){0u, 0u, 0u, 0u}; }
#pragma unroll
        for (int i = 0; i < 8; ++i) {
            const int row = r0 + i * NGW;
            if (row < MTOK) {
                float f[4][8]; float s = 0.f;
#pragma unroll
                for (int j = 0; j < 4; ++j) { f[j][0] = bflo(v[i][j].x); f[j][1] = bfhi(v[i][j].x); f[j][2] = bflo(v[i][j].y); f[j][3] = bfhi(v[i][j].y); f[j][4] = bflo(v[i][j].z); f[j][5] = bfhi(v[i][j].z); f[j][6] = bflo(v[i][j].w); f[j][7] = bfhi(v[i][j].w);
#pragma unroll
                    for (int e = 0; e < 8; ++e) s += f[j][e] * f[j][e]; }
                const float rstd = 1.0f / sqrtf(wave_sum(s) * (1.0f / DM) + EPS);
                float* orow = out + (size_t)row * DM + 8 * F.lane;
#pragma unroll
                for (int j = 0; j < 4; ++j) { const f32x4 g0 = *(const f32x4*)(g + 8 * F.lane + 512 * j), g1 = *(const f32x4*)(g + 8 * F.lane + 512 * j + 4);
                    f32x4 o0, o1;
#pragma unroll
                    for (int e = 0; e < 4; ++e) { o0[e] = f[j][e] * rstd * g0[e]; o1[e] = f[j][4 + e] * rstd * g1[e]; }
                    *(f32x4*)(orow + 512 * j) = o0; *(f32x4*)(orow + 512 * j + 4) = o1; }
            }
        }
    }
}

__device__ __forceinline__ void pool_phase(const Ctx& F, const bf16_t* proj, bf16_t* cat) {
    LAS unsigned char* T = F.lds;
    for (int blk = F.vcu; blk < MTOK / 64; blk += F.G) {
        const int b = blk >> 5, tb = (blk & 31) * 64;
        for (int hc = 0; hc < 2; ++hc) {
            int tid = F.tid; asm volatile("" : "+v"(tid));
            __syncthreads();
            { u32x4 r[10];
#pragma unroll
              for (int i = 0; i < 10; ++i) { const int idx = tid + 512 * i, row = idx >> 6, chn = idx & 63, gt = tb - 8 + row;
                  r[i] = (u32x4){0u, 0u, 0u, 0u};
                  if (gt >= 0 && gt < SEQ) r[i] = *(const u32x4*)(proj + ((size_t)b * SEQ + gt) * INW + hc * 512 + chn * 8); }
#pragma unroll
              for (int i = 0; i < 10; ++i) { const int idx = tid + 512 * i; *(LAS u32x4*)(T + idx * 16) = r[i]; } }
            __syncthreads();
            const int cgl = tid & 63, rg = tid >> 6;
            const int half = 1 << (hc * 2 + (cgl >> 5));
            const int t0 = tb + rg * 8;
            LAS unsigned char* col = T + cgl * 16;
            float S[8];
#pragma unroll
            for (int e = 0; e < 8; ++e) S[e] = 0.f;
            { const int lo = (t0 - half) > 0 ? (t0 - half) : 0, hi = (t0 + half) < SEQ ? (t0 + half) : SEQ;
              for (int j = lo; j < hi; ++j) { const u32x4 v = *(const LAS u32x4*)(col + (j - tb + 8) * 1024);
                  S[0] += bflo(v.x); S[1] += bfhi(v.x); S[2] += bflo(v.y); S[3] += bfhi(v.y); S[4] += bflo(v.z); S[5] += bfhi(v.z); S[6] += bflo(v.w); S[7] += bfhi(v.w); } }
#pragma unroll
            for (int i = 0; i < 8; ++i) {
                const int t = t0 + i;
                const int lo = (t - half) > 0 ? (t - half) : 0, hi = (t + half) < SEQ ? (t + half) : SEQ;
                const float rc = 1.0f / (float)(hi - lo);
                const u32x4 v = *(const LAS u32x4*)(col + (t - tb + 8) * 1024);
                u32x4 o;
                o.x = pk2(S[0] * rc - bflo(v.x), S[1] * rc - bfhi(v.x)); o.y = pk2(S[2] * rc - bflo(v.y), S[3] * rc - bfhi(v.y));
                o.z = pk2(S[4] * rc - bflo(v.z), S[5] * rc - bfhi(v.z)); o.w = pk2(S[6] * rc - bflo(v.w), S[7] * rc - bfhi(v.w));
                *(u32x4*)(cat + ((size_t)b * SEQ + t) * DM + hc * 512 + cgl * 8) = o;
                if (t + half < SEQ) { const u32x4 a = *(const LAS u32x4*)(col + (t + half - tb + 8) * 1024);
                    S[0] += bflo(a.x); S[1] += bfhi(a.x); S[2] += bflo(a.y); S[3] += bfhi(a.y); S[4] += bflo(a.z); S[5] += bfhi(a.z); S[6] += bflo(a.w); S[7] += bfhi(a.w); }
                if (t - half >= 0) { const u32x4 a = *(const LAS u32x4*)(col + (t - half - tb + 8) * 1024);
                    S[0] -= bflo(a.x); S[1] -= bfhi(a.x); S[2] -= bflo(a.y); S[3] -= bfhi(a.y); S[4] -= bflo(a.z); S[5] -= bfhi(a.z); S[6] -= bflo(a.w); S[7] -= bfhi(a.w); }
            }
        }
    }
    __syncthreads();
}

constexpr int RS = 544;
constexpr int RSV = 160;
__device__ __forceinline__ bf16x8 tr_pair(LAS unsigned char* p0, LAS unsigned char* p1) {
    const s16x4 a = __builtin_amdgcn_ds_read_tr16_b64_v4i16((LAS s16x4*)p0), b = __builtin_amdgcn_ds_read_tr16_b64_v4i16((LAS s16x4*)p1);
    return __builtin_shufflevector(a, b, 0, 1, 2, 3, 4, 5, 6, 7);
}
__device__ __forceinline__ bf16x8 pack8(const f32x4 a, const f32x4 b) {
    u32x4 w; w.x = pk2(a[0], a[1]); w.y = pk2(a[2], a[3]); w.z = pk2(b[0], b[1]); w.w = pk2(b[2], b[3]);
    return __builtin_bit_cast(bf16x8, w);
}

__device__ __forceinline__ void ret_chain_phase(const Ctx& F, const bf16_t* proj, bf16_t* yp, const float* dec_f, const float* dec_b) {
    LAS unsigned char* KT = F.lds; LAS unsigned char* VT = F.lds + 128 * RS; LAS unsigned char* ST = F.lds + 128 * RS + 128 * RSV;
    const int w = F.wave;
    for (int ch = F.vcu; ch < 256; ch += F.G) {
        int tid = F.tid; asm volatile("" : "+v"(tid));
        const int lane = tid & 63, fr = lane & 15, g4 = lane >> 4, q = fr >> 2, p = fr & 3;
        const int bh = ch >> 3, b = bh >> 2, h = bh & 3, dir = (ch >> 2) & 1, slab = ch & 3;
        const float lg = -__expf(dir ? dec_b[h] : dec_f[h]);
        const float l2 = lg * 1.44269504088896341f;
        f32x4 S[2][4];
#pragma unroll
        for (int dd = 0; dd < 2; ++dd)
#pragma unroll
            for (int et = 0; et < 4; ++et) S[dd][et] = (f32x4){0.f, 0.f, 0.f, 0.f};
        __syncthreads();
        for (int i = tid; i < 64 * RS / 16; i += 512) *(LAS u32x4*)(ST + i * 16) = (u32x4){0u, 0u, 0u, 0u};
        const float cdec = ex2(128.0f * l2);
        const int krow = tid >> 5, kc16 = tid & 31, vrow = tid >> 3, vc16 = tid & 7;
        u32x4 kreg[8], vreg[2]; bf16x8 qreg[8];
#define RC_PTRS(STEP) const int n_ = dir ? (NCHK - 1 - (STEP)) : (STEP); const size_t mm = (size_t)b * SEQ + (size_t)n_ * CHK; \
            const bf16_t* kp_ = proj + (mm + krow) * INW + 2048 + 256 * h + kc16 * 8; \
            const bf16_t* vp_ = proj + (mm + vrow) * INW + 3072 + 256 * h + 64 * slab + vc16 * 8; \
            const bf16_t* qp_ = proj + (mm + 16 * w + fr) * INW + 1024 + 256 * h + 8 * g4;
#define RC_LOAD_K(I0) do { kreg[(I0)] = *(const u32x4*)(kp_ + (size_t)(16 * (I0)) * INW); kreg[(I0) + 1] = *(const u32x4*)(kp_ + (size_t)(16 * ((I0) + 1)) * INW); } while (0)
#define RC_LOAD_Q(S0) do { qreg[(S0)] = *(const bf16x8*)(qp_ + 32 * (S0)); qreg[(S0) + 1] = *(const bf16x8*)(qp_ + 32 * ((S0) + 1)); } while (0)
#define RC_LOAD_V() do { vreg[0] = *(const u32x4*)(vp_); vreg[1] = *(const u32x4*)(vp_ + (size_t)64 * INW); } while (0)
        { RC_PTRS(0); RC_LOAD_K(0); RC_LOAD_K(2); RC_LOAD_K(4); RC_LOAD_K(6); RC_LOAD_V(); RC_LOAD_Q(0); RC_LOAD_Q(2); RC_LOAD_Q(4); RC_LOAD_Q(6); }
        for (int step = 0; step < NCHK; ++step) {
            const int n = dir ? (NCHK - 1 - step) : step;
            const size_t m0 = (size_t)b * SEQ + (size_t)n * CHK;
#pragma unroll
            for (int i = 0; i < 8; ++i) *(LAS u32x4*)(KT + (krow + 16 * i) * RS + kc16 * 16) = kreg[i];
#pragma unroll
            for (int i = 0; i < 2; ++i) { const int row = vrow + 64 * i; const u32x4 v = vreg[i];
                const float kd = ex2((float)(dir ? row : (CHK - 1 - row)) * l2);
                u32x4 o; o.x = pk2(bflo(v.x) * kd, bfhi(v.x) * kd); o.y = pk2(bflo(v.y) * kd, bfhi(v.y) * kd); o.z = pk2(bflo(v.z) * kd, bfhi(v.z) * kd); o.w = pk2(bflo(v.w) * kd, bfhi(v.w) * kd);
                *(LAS u32x4*)(VT + row * RSV + vc16 * 16) = o; }
            bf16x8 qf[8];
#pragma unroll
            for (int s = 0; s < 8; ++s) qf[s] = qreg[s];
            __syncthreads();
            const bool more = step + 1 < NCHK;
            RC_PTRS(more ? step + 1 : step);
            { f32x4 y[4];
              bf16x8 sfb[2][8];
#pragma unroll
              for (int s = 0; s < 8; ++s) sfb[0][s] = *(const LAS bf16x8*)(ST + (fr) * RS + (32 * s + 8 * g4) * 2);
#pragma unroll
              for (int et = 0; et < 4; ++et) { y[et] = (f32x4){0.f, 0.f, 0.f, 0.f};
                  if (et < 3) {
#pragma unroll
                      for (int s = 0; s < 8; ++s) sfb[(et + 1) & 1][s] = *(const LAS bf16x8*)(ST + (16 * (et + 1) + fr) * RS + (32 * s + 8 * g4) * 2); }
#pragma unroll
                  for (int s = 0; s < 8; ++s) y[et] = __builtin_amdgcn_mfma_f32_16x16x32_bf16(sfb[et & 1][s], qf[s], y[et], 0, 0, 0);
                  if (more) RC_LOAD_K(2 * et);
                  __builtin_amdgcn_sched_barrier(0); }
              const int ii = 16 * w + fr;
              const float a = ex2((float)(dir ? (CHK - ii) : (ii + 1)) * l2);
              bf16_t* yo = yp + ((size_t)dir * MTOK + m0 + ii) * 1024 + 256 * h + 64 * slab + 8 * g4;
#pragma unroll
              for (int jp = 0; jp < 2; ++jp) { u32x4 o; o.x = pk2(y[2 * jp][0] * a, y[2 * jp][1] * a); o.y = pk2(y[2 * jp][2] * a, y[2 * jp][3] * a);
                  o.z = pk2(y[2 * jp + 1][0] * a, y[2 * jp + 1][1] * a); o.w = pk2(y[2 * jp + 1][2] * a, y[2 * jp + 1][3] * a); *(u32x4*)(yo + 32 * jp) = o; } }
            if (step < NCHK - 1) {
#pragma unroll
                for (int dd = 0; dd < 2; ++dd)
#pragma unroll
                    for (int et = 0; et < 4; ++et) S[dd][et] *= cdec;
                bf16x8 kfb[2][2], vfb[2][4];
#define RC_FRAGS(BUF, SS) do { _Pragma("unroll") for (int dd = 0; dd < 2; ++dd) { LAS unsigned char* a0 = KT + (32 * (SS) + 8 * g4 + q) * RS + (32 * w + 16 * dd + 4 * p) * 2; kfb[BUF][dd] = tr_pair(a0, a0 + 4 * RS); } \
                    _Pragma("unroll") for (int et = 0; et < 4; ++et) { LAS unsigned char* b0 = VT + (32 * (SS) + 8 * g4 + q) * RSV + (16 * et + 4 * p) * 2; vfb[BUF][et] = tr_pair(b0, b0 + 4 * RSV); } } while (0)
                RC_FRAGS(0, 0);
#pragma unroll
                for (int s = 0; s < 4; ++s) {
                    if (s < 3) RC_FRAGS((s + 1) & 1, s + 1);
#pragma unroll
                    for (int dd = 0; dd < 2; ++dd)
#pragma unroll
                        for (int et = 0; et < 4; ++et) S[dd][et] = __builtin_amdgcn_mfma_f32_16x16x32_bf16(kfb[s & 1][dd], vfb[s & 1][et], S[dd][et], 0, 0, 0);
                    RC_LOAD_Q(2 * s); if (s == 0) RC_LOAD_V();
                    __builtin_amdgcn_sched_barrier(0);
                }
#undef RC_FRAGS
            }
            __syncthreads();
            if (step < NCHK - 1) {
#pragma unroll
                for (int dd = 0; dd < 2; ++dd)
#pragma unroll
                    for (int et = 0; et < 4; ++et) { u32x2 o; o.x = pk2(S[dd][et][0], S[dd][et][1]); o.y = pk2(S[dd][et][2], S[dd][et][3]);
                        *(LAS u32x2*)(ST + (16 * et + fr) * RS + (32 * w + 16 * dd + 4 * g4) * 2) = o; }
            }
        }
#undef RC_PTRS
#undef RC_LOAD_K
#undef RC_LOAD_Q
#undef RC_LOAD_V
    }
}

__device__ __forceinline__ void ret_out_phase(const Ctx& F, const bf16_t* proj, const bf16_t* yp, bf16_t* cat, const float* dec_f, const float* dec_b) {
    LAS unsigned char* KT = F.lds; LAS unsigned char* VT = F.lds + 128 * RS;
    const int tid_ = F.tid, w = F.wave;
    for (int u = F.vcu; u < BATCH * NHEAD * NCHK; u += F.G) {
        const int bh = u >> 4, b = bh >> 2, h = bh & 3, n = u & 15;
        const size_t m0 = (size_t)b * SEQ + (size_t)n * CHK;
        const float lf2 = -__expf(dec_f[h]) * 1.44269504088896341f, lb2 = -__expf(dec_b[h]) * 1.44269504088896341f;
        int tid = tid_; asm volatile("" : "+v"(tid));
        const int lane = tid & 63, fr = lane & 15, g4 = lane >> 4, q = fr >> 2, p = fr & 3;
        const size_t m = m0 + 16 * w + fr;
        bf16x8 qf[8];
        { u32x4 kreg[8], vreg[8];
          const int row = tid >> 5, c16 = tid & 31;
          const bf16_t* kp = proj + (m0 + row) * INW + 2048 + 256 * h + c16 * 8; const bf16_t* vp = kp + 1024;
#pragma unroll
          for (int i = 0; i < 8; ++i) kreg[i] = *(const u32x4*)(kp + (size_t)(16 * i) * INW);
#pragma unroll
          for (int i = 0; i < 8; ++i) vreg[i] = *(const u32x4*)(vp + (size_t)(16 * i) * INW);
          const bf16_t* qp = proj + m * INW + 1024 + 256 * h + 8 * g4;
#pragma unroll
          for (int s = 0; s < 8; ++s) qf[s] = *(const bf16x8*)(qp + 32 * s);
          __syncthreads();
#pragma unroll
          for (int i = 0; i < 8; ++i) *(LAS u32x4*)(KT + (row + 16 * i) * RS + c16 * 16) = kreg[i];
#pragma unroll
          for (int i = 0; i < 8; ++i) *(LAS u32x4*)(VT + (row + 16 * i) * RS + c16 * 16) = vreg[i]; }
        __syncthreads();
        u32x4 yfq[8], ybq[8], gq[8];
        { const bf16_t* yf = yp + m * 1024 + 256 * h + 8 * g4; const bf16_t* yb = yp + ((size_t)MTOK + m) * 1024 + 256 * h + 8 * g4; const bf16_t* gp = proj + m * INW + 4096 + 256 * h + 8 * g4;
#pragma unroll
          for (int j = 0; j < 8; ++j) { yfq[j] = *(const u32x4*)(yf + 32 * j); ybq[j] = *(const u32x4*)(yb + 32 * j); gq[j] = *(const u32x4*)(gp + 32 * j); } }
        bf16x8 pb[4];
        {
            f32x4 pt[8];
            bf16x8 kfb[2][8];
#pragma unroll
            for (int s = 0; s < 8; ++s) kfb[0][s] = *(const LAS bf16x8*)(KT + (fr) * RS + (32 * s + 8 * g4) * 2);
#pragma unroll
            for (int jt = 0; jt < 8; ++jt) { pt[jt] = (f32x4){0.f, 0.f, 0.f, 0.f};
                if (jt < 7) {
#pragma unroll
                    for (int s = 0; s < 8; ++s) kfb[(jt + 1) & 1][s] = *(const LAS bf16x8*)(KT + (16 * (jt + 1) + fr) * RS + (32 * s + 8 * g4) * 2); }
#pragma unroll
                for (int s = 0; s < 8; ++s) pt[jt] = __builtin_amdgcn_mfma_f32_16x16x32_bf16(kfb[jt & 1][s], qf[s], pt[jt], 0, 0, 0);
                __builtin_amdgcn_sched_barrier(0); }
            const int il = 16 * w + fr;
#pragma unroll
            for (int jt = 0; jt < 8; ++jt)
#pragma unroll
                for (int r = 0; r < 4; ++r) { const int df = il - (16 * jt + 4 * g4 + r);
                    const float dcy = df >= 0 ? ex2((float)df * lf2) : ex2((float)(-df) * lb2);
                    pt[jt][r] *= dcy; }
#pragma unroll
            for (int s = 0; s < 4; ++s) pb[s] = pack8(pt[2 * s], pt[2 * s + 1]);
        }
        f32x4 ot[16];
#pragma unroll
        for (int et = 0; et < 16; ++et) ot[et] = (f32x4){0.f, 0.f, 0.f, 0.f};
        {
            bf16x8 vfb[2][8];
#define RO_FRAGS(BUF, B8) do { _Pragma("unroll") for (int e8 = 0; e8 < 8; ++e8) { LAS unsigned char* a0 = VT + (32 * ((B8) >> 1) + 4 * g4 + q) * RS + (16 * (8 * ((B8) & 1) + e8) + 4 * p) * 2; vfb[BUF][e8] = tr_pair(a0, a0 + 16 * RS); } } while (0)
            RO_FRAGS(0, 0);
#pragma unroll
            for (int b8 = 0; b8 < 8; ++b8) {
                if (b8 < 7) RO_FRAGS((b8 + 1) & 1, b8 + 1);
#pragma unroll
                for (int e8 = 0; e8 < 8; ++e8) ot[8 * (b8 & 1) + e8] = __builtin_amdgcn_mfma_f32_16x16x32_bf16(vfb[b8 & 1][e8], pb[b8 >> 1], ot[8 * (b8 & 1) + e8], 0, 0, 0);
                __builtin_amdgcn_sched_barrier(0);
            }
#undef RO_FRAGS
        }
        float ss = 0.f;
#pragma unroll
        for (int j = 0; j < 8; ++j) {
            ot[2 * j][0] += bflo(yfq[j].x) + bflo(ybq[j].x); ot[2 * j][1] += bfhi(yfq[j].x) + bfhi(ybq[j].x); ot[2 * j][2] += bflo(yfq[j].y) + bflo(ybq[j].y); ot[2 * j][3] += bfhi(yfq[j].y) + bfhi(ybq[j].y);
            ot[2 * j + 1][0] += bflo(yfq[j].z) + bflo(ybq[j].z); ot[2 * j + 1][1] += bfhi(yfq[j].z) + bfhi(ybq[j].z); ot[2 * j + 1][2] += bflo(yfq[j].w) + bflo(ybq[j].w); ot[2 * j + 1][3] += bfhi(yfq[j].w) + bfhi(ybq[j].w);
#pragma unroll
            for (int t = 0; t < 2; ++t) ss += (ot[2 * j + t][0] * ot[2 * j + t][0] + ot[2 * j + t][1] * ot[2 * j + t][1]) + (ot[2 * j + t][2] * ot[2 * j + t][2] + ot[2 * j + t][3] * ot[2 * j + t][3]); }
        ss += __shfl_xor(ss, 16); ss += __shfl_xor(ss, 32);
        const float rstd = 1.0f / sqrtf(ss * (1.0f / DH) + EPS);
        bf16_t* op = cat + m * DM + 1024 + 256 * h + 8 * g4;
#pragma unroll
        for (int j = 0; j < 8; ++j) {
            u32x4 o;
            o.x = pk2(pg8::fast_silu(bflo(gq[j].x)) * ot[2 * j][0] * rstd, pg8::fast_silu(bfhi(gq[j].x)) * ot[2 * j][1] * rstd);
            o.y = pk2(pg8::fast_silu(bflo(gq[j].y)) * ot[2 * j][2] * rstd, pg8::fast_silu(bfhi(gq[j].y)) * ot[2 * j][3] * rstd);
            o.z = pk2(pg8::fast_silu(bflo(gq[j].z)) * ot[2 * j + 1][0] * rstd, pg8::fast_silu(bfhi(gq[j].z)) * ot[2 * j + 1][1] * rstd);
            o.w = pk2(pg8::fast_silu(bflo(gq[j].w)) * ot[2 * j + 1][2] * rstd, pg8::fast_silu(bfhi(gq[j].w)) * ot[2 * j + 1][3] * rstd);
            *(u32x4*)(op + 32 * j) = o; }
    }
}

constexpr int NPHASE = 10;
struct Args { const float* in[16]; float* out; unsigned char* ws; int ph_lo, ph_hi; };
__global__ void __launch_bounds__(512, 2) fwd_kernel(Args args) {
    extern __shared__ __attribute__((aligned(16))) unsigned char lds_raw[];
    Ctx F;
    F.lds = (LAS unsigned char*)lds_raw;
    F.tid = threadIdx.x; F.lane = F.tid & 63; F.wave = __builtin_amdgcn_readfirstlane(F.tid >> 6);
    F.G = gridDim.x; { const int bx = blockIdx.x; F.vcu = (F.G % 8 == 0) ? (bx % 8) * (F.G / 8) + bx / 8 : bx; }
    unsigned char* ws = args.ws;
    gu32* ctl = (gu32*)(ws + WS_CTL);
    volatile LAS unsigned* MISC = (volatile LAS unsigned*)(F.lds + LDSCTL_OFF);
    for (int u = F.tid; u < (LDS_BYTES - LDSCTL_OFF) / 4; u += 512) ((LAS unsigned*)(F.lds + LDSCTL_OFF))[u] = 0u;
    __syncthreads();
    const int lo = args.ph_lo, hi = args.ph_hi;
    const bool multi = (hi - lo) > 1;
    XcdBarrier bar; bar.bar = (unsigned*)(ctl + CW_BAR); bar.x = 0; bar.st = nullptr;
    if (multi) bar = xcd_barrier_post((unsigned*)(ctl + CW_BAR), MISC + 8);
#ifndef PHASE_MASK
#define PHASE_MASK 0x3ff
#endif
#define IN(k) (((PHASE_MASK >> (k)) & 1) && lo <= (k) && (k) < hi)
#define SEAM(k) do { if (IN(k) && IN((k) + 1)) xcd_barrier(bar); { int t_ = threadIdx.x; asm volatile("" : "+v"(t_)); F.tid = t_; F.lane = t_ & 63; F.wave = __builtin_amdgcn_readfirstlane(t_ >> 6); } } while (0)
    const float* x = args.in[0]; const float* c = args.in[1]; const float* w_ada = args.in[2]; const float* b_ada = args.in[3]; const float* norm1_g = args.in[4];
    const float* w_in = args.in[5]; const float* pool_w = args.in[6]; const float* pool_scale = args.in[7]; const float* dec_f = args.in[8]; const float* dec_b = args.in[9];
    const float* w_out = args.in[10]; const float* norm2_g = args.in[11]; const float* w_gate = args.in[12]; const float* w_up = args.in[13]; const float* w_down = args.in[14]; const float* final_g = args.in[15];
    float* out = args.out;
    bf16_t* WinT = (bf16_t*)(ws + WS_WIN); bf16_t* WoT = (bf16_t*)(ws + WS_WO); bf16_t* WguT = (bf16_t*)(ws + WS_WGU); bf16_t* WdT = (bf16_t*)(ws + WS_WD);
    float* modp = (float*)(ws + WS_MODP); float* mod = (float*)(ws + WS_MOD); float* cosT = (float*)(ws + WS_ROPE); float* sinT = cosT + SEQ * 128;
    bf16_t* H = (bf16_t*)(ws + WS_H); bf16_t* CAT = (bf16_t*)(ws + WS_CAT); bf16_t* PROJ = (bf16_t*)(ws + WS_PROJ); bf16_t* ACT = (bf16_t*)(ws + WS_ACT);
    bf16_t* X1 = (bf16_t*)out;
    bf16_t* X2 = (bf16_t*)(ws + WS_H);

#ifndef REPEAT_MASK
#define REPEAT_MASK 0
#endif
#define REP(k) for (int rep_ = 0; rep_ < 1 + ((REPEAT_MASK >> (k)) & 1); ++rep_)
    if (IN(0)) REP(0) { P0Args A{c, w_ada, w_in, pool_w, pool_scale, w_out, w_gate, w_up, w_down, WinT, WoT, WguT, WdT, modp, cosT, sinT}; p0_prologue(F, A); __syncthreads(); }
    SEAM(0);
    if (IN(1)) REP(1) { norm_mod_phase<0>(F, x, H, norm1_g, modp, b_ada, mod, 0, 1); }
    SEAM(1);
    if (IN(2)) REP(2) { pg8::Gemm g{H, WinT, MTOK, INW, DM}; pg8::StaticOrder S; S.init(MTOK, INW, F.G, (int)blockIdx.x); pg8::EpiProj E{PROJ, cosT, sinT};
        pg8::gemm_phase<pg8::EpiProj, pg8::StaticOrder, true, true>(F.lds, g, S, E); }
    SEAM(2);
    if (IN(3)) REP(3) { pool_phase(F, PROJ, CAT); ret_chain_phase(F, PROJ, (bf16_t*)out, dec_f, dec_b); }
    SEAM(3);
    if (IN(4)) REP(4) { ret_out_phase(F, PROJ, (const bf16_t*)out, CAT, dec_f, dec_b); }
    SEAM(4);
    if (IN(5)) REP(5) { pg8::Gemm g{CAT, WoT, MTOK, DM, DM}; pg8::StaticOrder S; S.init(MTOK, DM, F.G, (int)blockIdx.x); pg8::EpiRes<false> E{x, X1, mod + 2 * DM};
        pg8::gemm_phase<pg8::EpiRes<false>, pg8::StaticOrder, true, true>(F.lds, g, S, E); }
    SEAM(5);
    if (IN(6)) REP(6) { norm_mod_bf16_phase(F, X1, H, norm2_g, mod, 3, 4); }
    SEAM(6);
    if (IN(7)) REP(7) { pg8::Gemm g{H, WguT, MTOK, 2 * FF, DM}; pg8::StaticOrder S; S.init(MTOK, 2 * FF, F.G, (int)blockIdx.x); pg8::EpiSwiGLU E{ACT};
        pg8::gemm_phase<pg8::EpiSwiGLU, pg8::StaticOrder, true, true>(F.lds, g, S, E); }
    SEAM(7);
    if (IN(8)) REP(8) { pg8::Gemm g{ACT, WdT, MTOK, DM, FF}; pg8::StaticOrder S; S.init(MTOK, DM, F.G, (int)blockIdx.x); pg8::EpiRes<true> E{X1, X2, mod + 5 * DM};
        pg8::gemm_phase<pg8::EpiRes<true>, pg8::StaticOrder, true, true>(F.lds, g, S, E); }
    SEAM(8);
    if (IN(9)) REP(9) { final_norm_phase(F, X2, out, final_g); }
#undef IN
#undef SEAM
}

#ifndef MK_PER_PHASE
#define MK_PER_PHASE 0
#endif
extern "C" void kernel_launch(void* const* d_in, const int* in_sizes, int n_in, void* d_out, int out_size, void* d_ws, size_t ws_size, hipStream_t stream) {
    static int grid = 0;
    if (grid == 0) {
        if (n_in != 16 || in_sizes[0] != MTOK * DM || out_size != MTOK * DM || ws_size < WS_END) { fprintf(stderr, "kernel_launch: unexpected shapes (n_in %d, in0 %d, out %d, ws %zu)\n", n_in, n_in > 0 ? in_sizes[0] : -1, out_size, ws_size); grid = -1; return; }
        int dev = 0, cus = 0, per_cu = 0;
        if (hipGetDevice(&dev) != hipSuccess || hipDeviceGetAttribute(&cus, hipDeviceAttributeMultiprocessorCount, dev) != hipSuccess) { grid = -1; return; }
        if (hipFuncSetAttribute((const void*)fwd_kernel, hipFuncAttributeMaxDynamicSharedMemorySize, LDS_BYTES) != hipSuccess) { fprintf(stderr, "kernel_launch: hipFuncSetAttribute failed\n"); grid = -1; return; }
        if (hipOccupancyMaxActiveBlocksPerMultiprocessor(&per_cu, (const void*)fwd_kernel, 512, LDS_BYTES) != hipSuccess || per_cu < 1) { fprintf(stderr, "kernel_launch: occupancy query says %d blocks per CU\n", per_cu); }
        (void)hipGetLastError();
        grid = cus;
    }
    if (grid < 0) return;
    if (hipMemsetAsync((char*)d_ws + WS_CTL, 0, CTL_ZERO_BYTES, stream) != hipSuccess) return;
    Args a{};
    for (int i = 0; i < 16; ++i) a.in[i] = (const float*)d_in[i];
    a.out = (float*)d_out; a.ws = (unsigned char*)d_ws;
#if MK_PER_PHASE
    for (int ph = 0; ph < NPHASE; ++ph) { a.ph_lo = ph; a.ph_hi = ph + 1; hipLaunchKernelGGL(fwd_kernel, dim3(grid), dim3(512), LDS_BYTES, stream, a); }
#else
    a.ph_lo = 0; a.ph_hi = NPHASE;
    hipLaunchKernelGGL(fwd_kernel, dim3(grid), dim3(512), LDS_BYTES, stream, a);
#endif
}
```

```cpp
#include <hip/hip_runtime.h>
#include <cstdio>
#include <cstdint>

#define LAS __attribute__((address_space(3)))
#define GAS __attribute__((address_space(1)))
typedef unsigned short bf16_t;
typedef short bf16x8 __attribute__((ext_vector_type(8)));
typedef short s16x4 __attribute__((ext_vector_type(4)));
typedef float f32x4 __attribute__((ext_vector_type(4)));
typedef float f32x2 __attribute__((ext_vector_type(2)));
typedef unsigned u32x4 __attribute__((ext_vector_type(4)));
typedef unsigned u32x2 __attribute__((ext_vector_type(2)));
typedef GAS unsigned gu32;

constexpr int BATCH = 8, SEQ = 2048, DM = 2048, MTOK = BATCH * SEQ;
constexpr int POOLW = 1024, NHEAD = 4, DH = 256, CHK = 128, NCHK = SEQ / CHK;
constexpr int FF = 5632, INW = 5120, NMODW = 6 * DM;
constexpr float EPS = 1e-6f;
constexpr int ADA_KC = 16;

constexpr size_t MiB = 1u << 20;
constexpr size_t WS_CTL = 0, CTL_ZERO_BYTES = 65536;
constexpr size_t WS_WIN = 1 * MiB, WS_WO = 21 * MiB, WS_WGU = 29 * MiB, WS_WD = 73 * MiB;
constexpr size_t WS_MODP = 95 * MiB, WS_MOD = 102 * MiB, WS_ROPE = 103 * MiB;
constexpr size_t WS_H = 170 * MiB, WS_CAT = 106 * MiB, WS_PROJ = 234 * MiB, WS_ACT = 234 * MiB, WS_END = 410 * MiB;
constexpr int CW_TMO = 0, CW_BAR = 4096;

constexpr int RING_BYTES = 143360, LDSCTL_OFF = RING_BYTES, LDS_BYTES = 147456;

namespace pg8 {
constexpr int BM = 256, BK = 64, HALF = 128, HTB = HALF * BK * 2, STAGE_BYTES = 8 * HTB, NXCD = 8, WGM = 4;
__host__ __device__ __forceinline__ int lds_byte(int r, int c) { const int st = (r >> 4) * 2 + (c >> 5), rr = r & 15, cc = c & 31, ob = rr * 64 + cc * 2; return st * 1024 + (ob ^ (((ob >> 9) & 1) << 5)); }
__host__ __device__ __forceinline__ void stage_rc(int b, int& R, int& C) { const int st = b / 1024, sb = b % 1024, swz = sb ^ (((sb >> 9) & 1) << 5); R = (st >> 1) * 16 + swz / 64; C = (st & 1) * 32 + (swz % 64) / 2; }
__host__ __device__ __forceinline__ int perm32(int rho) { const int n = rho >> 4, i = rho & 15; return 8 * (i >> 2) + 4 * n + (i & 3); }

struct Unit { int pm, pn; };
struct Gemm { const bf16_t* A; const bf16_t* Bt; int M, N, K; };

struct StaticOrder {
    int nM, nN, nwg, G, c;
    __host__ __device__ void init(int M, int N, int G_, int c_) { nM = M / BM; nN = N / BM; nwg = nM * nN; G = G_; c = c_; }
    __host__ __device__ bool next(int i, Unit& u) const {
        const long L = (long)i * G + c; if (L >= nwg) return false;
        int wgid = (int)L; { const int q = nwg / NXCD, r = nwg % NXCD, xcd = wgid % NXCD, off = wgid / NXCD; wgid = (xcd < r ? xcd * (q + 1) : r * (q + 1) + (xcd - r) * q) + off; }
        const int nig = WGM * nN, gid = wgid / nig, fm = gid * WGM, gsz = (nM - fm) < WGM ? (nM - fm) : WGM;
        u.pm = fm + ((wgid % nig) % gsz); u.pn = (wgid % nig) / gsz; return true;
    }
    __device__ __forceinline__ void a_ready(const Unit&) const {}
    __device__ __forceinline__ void done(const Unit&) const {}
};

__device__ __forceinline__ unsigned cvt_pk_bf16(float lo, float hi) { unsigned r; asm volatile("v_cvt_pk_bf16_f32 %0, %1, %2" : "=v"(r) : "v"(lo), "v"(hi)); return r; }
__device__ __forceinline__ float bflo_(unsigned w) { return __builtin_bit_cast(float, w << 16); }
__device__ __forceinline__ float bfhi_(unsigned w) { return __builtin_bit_cast(float, w & 0xffff0000u); }
__device__ __forceinline__ float fast_silu(float v) { return v * __builtin_amdgcn_rcpf(1.0f + __expf(-v)); }

struct EpiProj {
    static constexpr bool PERM = true, AFTER_DRAIN = false;
    bf16_t* O; const float* cosT; const float* sinT;
    __device__ __forceinline__ void operator()(f32x4 (&acc)[2][2][4][2], const Unit& u, int wr, int wc, int fr, int fq) const {
        const int row0 = u.pm * BM + wr * 64 + fr, col0 = u.pn * BM + wc * 32 + 8 * fq;
        const bool rot = (u.pn >= 4) && (u.pn < 12); const float qs = (u.pn < 8) ? 0.0625f : 1.0f;
        const int jj0 = wc * 32 + 8 * fq;
#pragma unroll
        for (int ai = 0; ai < 2; ++ai)
#pragma unroll
            for (int m = 0; m < 4; ++m) {
                const int row = row0 + ai * HALF + m * 16; bf16_t* rowp = O + (size_t)row * INW + col0;
                f32x4 a0 = acc[ai][0][m][0], a1 = acc[ai][0][m][1], b0 = acc[ai][1][m][0], b1 = acc[ai][1][m][1];
                if (rot) {
                    const int pos = row & (SEQ - 1);
                    const f32x4 c0 = *(const f32x4*)(cosT + pos * 128 + jj0), c1 = *(const f32x4*)(cosT + pos * 128 + jj0 + 4);
                    const f32x4 s0 = *(const f32x4*)(sinT + pos * 128 + jj0), s1 = *(const f32x4*)(sinT + pos * 128 + jj0 + 4);
                    const f32x4 o10 = (a0 * c0 - b0 * s0) * qs, o11 = (a1 * c1 - b1 * s1) * qs;
                    const f32x4 o20 = (a0 * s0 + b0 * c0) * qs, o21 = (a1 * s1 + b1 * c1) * qs;
                    a0 = o10; a1 = o11; b0 = o20; b1 = o21;
                }
                u32x4 w0, w1;
                w0.x = cvt_pk_bf16(a0[0], a0[1]); w0.y = cvt_pk_bf16(a0[2], a0[3]); w0.z = cvt_pk_bf16(a1[0], a1[1]); w0.w = cvt_pk_bf16(a1[2], a1[3]);
                w1.x = cvt_pk_bf16(b0[0], b0[1]); w1.y = cvt_pk_bf16(b0[2], b0[3]); w1.z = cvt_pk_bf16(b1[0], b1[1]); w1.w = cvt_pk_bf16(b1[2], b1[3]);
                *(u32x4*)(rowp) = w0; *(u32x4*)(rowp + HALF) = w1;
            }
    }
};
template <bool BASE_BF16> struct EpiRes {
    static constexpr bool PERM = true, AFTER_DRAIN = false;
    const void* base; bf16_t* out; const float* gv;
    __device__ __forceinline__ void operator()(f32x4 (&acc)[2][2][4][2], const Unit& u, int wr, int wc, int fr, int fq) const {
        const int col0 = u.pn * BM + wc * 32 + 8 * fq; const int b = u.pm >> 3;
        f32x4 g[2][2];
#pragma unroll
        for (int bj = 0; bj < 2; ++bj)
#pragma unroll
            for (int n = 0; n < 2; ++n) g[bj][n] = *(const f32x4*)(gv + (size_t)b * NMODW + col0 + bj * HALF + n * 4);
#pragma unroll
        for (int ai = 0; ai < 2; ++ai) {
            if constexpr (BASE_BF16) {
                u32x4 pre[4][2];
#pragma unroll
                for (int m = 0; m < 4; ++m) { const size_t off = (size_t)(u.pm * BM + ai * HALF + wr * 64 + m * 16 + fr) * DM + col0;
#pragma unroll
                    for (int bj = 0; bj < 2; ++bj) pre[m][bj] = *(const u32x4*)((const bf16_t*)base + off + bj * HALF); }
#pragma unroll
                for (int m = 0; m < 4; ++m) { const size_t off = (size_t)(u.pm * BM + ai * HALF + wr * 64 + m * 16 + fr) * DM + col0;
#pragma unroll
                    for (int bj = 0; bj < 2; ++bj) { const u32x4 p = pre[m][bj]; const f32x4 a0 = acc[ai][bj][m][0] * g[bj][0], a1 = acc[ai][bj][m][1] * g[bj][1];
                        u32x4 w; w.x = cvt_pk_bf16(bflo_(p.x) + a0[0], bfhi_(p.x) + a0[1]); w.y = cvt_pk_bf16(bflo_(p.y) + a0[2], bfhi_(p.y) + a0[3]);
                        w.z = cvt_pk_bf16(bflo_(p.z) + a1[0], bfhi_(p.z) + a1[1]); w.w = cvt_pk_bf16(bflo_(p.w) + a1[2], bfhi_(p.w) + a1[3]);
                        *(u32x4*)(out + off + bj * HALF) = w; } }
            } else {
                f32x4 pre[4][2][2];
#pragma unroll
                for (int m = 0; m < 4; ++m) { const size_t off = (size_t)(u.pm * BM + ai * HALF + wr * 64 + m * 16 + fr) * DM + col0;
#pragma unroll
                    for (int bj = 0; bj < 2; ++bj)
#pragma unroll
                        for (int n = 0; n < 2; ++n) pre[m][bj][n] = *(const f32x4*)((const float*)base + off + bj * HALF + n * 4); }
#pragma unroll
                for (int m = 0; m < 4; ++m) { const size_t off = (size_t)(u.pm * BM + ai * HALF + wr * 64 + m * 16 + fr) * DM + col0;
#pragma unroll
                    for (int bj = 0; bj < 2; ++bj) { const f32x4 v0 = pre[m][bj][0] + acc[ai][bj][m][0] * g[bj][0], v1 = pre[m][bj][1] + acc[ai][bj][m][1] * g[bj][1];
                        u32x4 w; w.x = cvt_pk_bf16(v0[0], v0[1]); w.y = cvt_pk_bf16(v0[2], v0[3]); w.z = cvt_pk_bf16(v1[0], v1[1]); w.w = cvt_pk_bf16(v1[2], v1[3]);
                        *(u32x4*)(out + off + bj * HALF) = w; } }
            }
            asm volatile("" ::: "memory");
        }
    }
};
struct EpiSwiGLU {
    static constexpr bool PERM = true, AFTER_DRAIN = false;
    bf16_t* O;
    __device__ __forceinline__ void operator()(f32x4 (&acc)[2][2][4][2], const Unit& u, int wr, int wc, int fr, int fq) const {
        const int row0 = u.pm * BM + wr * 64 + fr, col0 = u.pn * HALF + wc * 32 + 8 * fq;
#pragma unroll
        for (int ai = 0; ai < 2; ++ai)
#pragma unroll
            for (int m = 0; m < 4; ++m) {
                bf16_t* rowp = O + (size_t)(row0 + ai * HALF + m * 16) * FF + col0;
                const f32x4 g0 = acc[ai][0][m][0], g1 = acc[ai][0][m][1], u0 = acc[ai][1][m][0], u1 = acc[ai][1][m][1];
                f32x4 o0, o1;
#pragma unroll
                for (int e = 0; e < 4; ++e) { o0[e] = fast_silu(g0[e]) * u0[e]; o1[e] = fast_silu(g1[e]) * u1[e]; }
                u32x4 w; w.x = cvt_pk_bf16(o0[0], o0[1]); w.y = cvt_pk_bf16(o0[2], o0[3]); w.z = cvt_pk_bf16(o1[0], o1[1]); w.w = cvt_pk_bf16(o1[2], o1[3]);
                *(u32x4*)rowp = w;
            }
    }
};

template <class Epi, class Sched, bool ALIGN_EPI = false, bool SP2 = false>
__device__ __forceinline__ void gemm_phase(LAS unsigned char* lds, const Gemm g, const Sched& S, const Epi& E) {
    int tid = threadIdx.x; asm volatile("" : "+v"(tid));
    const int wid = __builtin_amdgcn_readfirstlane(tid >> 6), lane = tid & 63, wr = wid >> 2, wc = wid & 3, fr = lane & 15, fq = lane >> 4;
    const int K = g.K, nt = K / BK;
    unsigned voffA[2], voffB[2];
#pragma unroll
    for (int i = 0; i < 2; ++i) { int R, C; stage_rc(tid * 16 + i * 8192, R, C); const int Rb = Epi::PERM ? ((R & ~31) + perm32(R & 31)) : R;
        voffA[i] = (unsigned)(R * K + C) * 2u; voffB[i] = (unsigned)(Rb * K + C) * 2u; }
    const size_t kstep = (size_t)(BK * 2);
    const size_t hstep = (size_t)HALF * K * 2;
    const size_t tstep = 2 * hstep;
    const unsigned ldsw = (unsigned)wid * 1024u;
    const int aoff = lds_byte(wr * 64 + fr, fq * 8), boff = lds_byte(wc * 32 + fr, fq * 8);
#define PG8_SA(b, h) (((b) * 2 + (h)) * HTB)
#define PG8_SB(b, h) ((4 + (b) * 2 + (h)) * HTB)
#define PG8_STAGE(bufoff, gbase, voff) do { _Pragma("unroll") for (int _i = 0; _i < 2; ++_i) \
        __builtin_amdgcn_global_load_lds((const unsigned*)((const char*)(gbase) + (voff)[_i]), (LAS unsigned*)(lds + (bufoff) + ldsw + _i * 8192), 16, 0, 0); } while (0)
#define PG8_LDA(dst, b, h) do { _Pragma("unroll") for (int m = 0; m < 4; ++m) _Pragma("unroll") for (int k = 0; k < 2; ++k) dst[m][k] = *(const LAS bf16x8*)(lds + PG8_SA(b, h) + aoff + m * 2048 + k * 1024); } while (0)
#define PG8_LDB(dst, b, h) do { _Pragma("unroll") for (int n = 0; n < 2; ++n) _Pragma("unroll") for (int k = 0; k < 2; ++k) dst[n][k] = *(const LAS bf16x8*)(lds + PG8_SB(b, h) + boff + n * 2048 + k * 1024); } while (0)
#define PG8_MMA(ai, bj, At, Bt) do { __builtin_amdgcn_s_setprio(1); _Pragma("unroll") for (int k = 0; k < 2; ++k) _Pragma("unroll") for (int m = 0; m < 4; ++m) _Pragma("unroll") for (int n = 0; n < 2; ++n) \
        acc[ai][bj][m][n] = __builtin_amdgcn_mfma_f32_16x16x32_bf16(Bt[n][k], At[m][k], acc[ai][bj][m][n], 0, 0, 0); __builtin_amdgcn_s_setprio(0); } while (0)
#define PG8_WAIT_V(n) asm volatile("s_waitcnt vmcnt(" #n ")" ::: "memory")
#define PG8_WAIT_L(n) asm volatile("s_waitcnt lgkmcnt(" #n ")" ::: "memory")
#define PG8_BAR __builtin_amdgcn_s_barrier()
#define PG8_SCHED __builtin_amdgcn_sched_barrier(0)
    Unit cur, nxt; int ui = 0;
    if (!S.next(0, cur)) return;
    f32x4 acc[2][2][4][2];
#pragma unroll
    for (int a = 0; a < 2; ++a)
#pragma unroll
        for (int b = 0; b < 2; ++b)
#pragma unroll
            for (int m = 0; m < 4; ++m)
#pragma unroll
                for (int n = 0; n < 2; ++n) acc[a][b][m][n] = (f32x4){0.f, 0.f, 0.f, 0.f};
    bf16x8 At[4][2], B0[2][2], B1[2][2];
    const char* cA = (const char*)g.A + (size_t)cur.pm * tstep; const char* cB = (const char*)g.Bt + (size_t)cur.pn * tstep;
    S.a_ready(cur);
    if constexpr (SP2) {
        PG8_STAGE(PG8_SB(0, 0), cB, voffB); PG8_STAGE(PG8_SB(0, 1), cB + hstep, voffB); PG8_STAGE(PG8_SA(0, 0), cA, voffA); PG8_STAGE(PG8_SA(0, 1), cA + hstep, voffA);
        if (wr == 1) PG8_BAR;
        PG8_WAIT_V(2); PG8_BAR;
        PG8_STAGE(PG8_SB(1, 0), cB + kstep, voffB); PG8_STAGE(PG8_SA(1, 0), cA + kstep, voffA); PG8_STAGE(PG8_SB(1, 1), cB + hstep + kstep, voffB);
        PG8_WAIT_V(6); PG8_BAR;
    } else {
        PG8_STAGE(PG8_SB(0, 0), cB, voffB); PG8_STAGE(PG8_SA(0, 0), cA, voffA); PG8_STAGE(PG8_SB(0, 1), cB + hstep, voffB); PG8_STAGE(PG8_SA(0, 1), cA + hstep, voffA);
        if (wr == 1) PG8_BAR;
        PG8_WAIT_V(4); PG8_BAR;
        PG8_STAGE(PG8_SB(1, 0), cB + kstep, voffB); PG8_STAGE(PG8_SA(1, 0), cA + kstep, voffA); PG8_STAGE(PG8_SB(1, 1), cB + hstep + kstep, voffB);
        PG8_WAIT_V(6); PG8_BAR;
    }
    for (;;) {
        const bool has_next = S.next(ui + 1, nxt);
        const char* nA = has_next ? (const char*)g.A + (size_t)nxt.pm * tstep : cA; const char* nB = has_next ? (const char*)g.Bt + (size_t)nxt.pn * tstep : cB;
        for (int t = 0; t < nt; t += 2) {
            const bool last = (t == nt - 2);
            const char* a1 = cA + (size_t)(t + 1) * kstep;
            const char* a2 = last ? nA : cA + (size_t)(t + 2) * kstep; const char* b2 = last ? nB : cB + (size_t)(t + 2) * kstep;
            const char* a3 = a2 + kstep; const char* b3 = b2 + kstep;
            if (last && has_next) S.a_ready(nxt);
            if constexpr (SP2) {
            PG8_LDB(B0, 0, 0); PG8_LDB(B1, 0, 1); PG8_SCHED; PG8_LDA(At, 0, 0); PG8_STAGE(PG8_SA(1, 1), a1 + hstep, voffA);
            PG8_WAIT_V(8); PG8_WAIT_L(0); PG8_BAR; PG8_MMA(0, 0, At, B0); PG8_MMA(0, 1, At, B1); PG8_BAR; PG8_SCHED;
            PG8_LDA(At, 0, 1); PG8_STAGE(PG8_SB(0, 0), b2, voffB); PG8_STAGE(PG8_SB(0, 1), b2 + hstep, voffB); PG8_STAGE(PG8_SA(0, 0), a2, voffA);
            PG8_WAIT_V(8); PG8_WAIT_L(0); PG8_BAR; PG8_MMA(1, 0, At, B0); PG8_MMA(1, 1, At, B1); PG8_BAR; PG8_SCHED;
            PG8_LDB(B0, 1, 0); PG8_LDB(B1, 1, 1); PG8_SCHED; PG8_LDA(At, 1, 0); PG8_STAGE(PG8_SA(0, 1), a2 + hstep, voffA);
            PG8_WAIT_V(8); PG8_WAIT_L(0); PG8_BAR; PG8_MMA(0, 0, At, B0); PG8_MMA(0, 1, At, B1); PG8_BAR; PG8_SCHED;
            PG8_LDA(At, 1, 1); PG8_STAGE(PG8_SB(1, 0), b3, voffB); PG8_STAGE(PG8_SB(1, 1), b3 + hstep, voffB); PG8_STAGE(PG8_SA(1, 0), a3, voffA);
            PG8_WAIT_V(8); PG8_WAIT_L(0); PG8_BAR; PG8_MMA(1, 0, At, B0); PG8_MMA(1, 1, At, B1); PG8_BAR; PG8_SCHED;
            } else {
            PG8_LDB(B0, 0, 0); PG8_SCHED; PG8_LDA(At, 0, 0); PG8_STAGE(PG8_SA(1, 1), a1 + hstep, voffA);
            PG8_WAIT_L(8); PG8_BAR; PG8_WAIT_L(0); PG8_MMA(0, 0, At, B0); PG8_BAR; PG8_SCHED;
            PG8_LDB(B1, 0, 1); PG8_STAGE(PG8_SB(0, 0), b2, voffB);
            PG8_BAR; PG8_WAIT_L(0); PG8_MMA(0, 1, At, B1); PG8_BAR;
            PG8_LDA(At, 0, 1); PG8_STAGE(PG8_SA(0, 0), a2, voffA);
            PG8_BAR; PG8_WAIT_L(0); PG8_MMA(1, 0, At, B0); PG8_BAR; PG8_SCHED;
            PG8_STAGE(PG8_SB(0, 1), b2 + hstep, voffB);
            PG8_WAIT_V(6); PG8_BAR; PG8_MMA(1, 1, At, B1); PG8_BAR;
            PG8_LDB(B0, 1, 0); PG8_SCHED; PG8_LDA(At, 1, 0); PG8_STAGE(PG8_SA(0, 1), a2 + hstep, voffA);
            PG8_WAIT_L(8); PG8_BAR; PG8_WAIT_L(0); PG8_MMA(0, 0, At, B0); PG8_BAR; PG8_SCHED;
            PG8_LDB(B1, 1, 1); PG8_STAGE(PG8_SB(1, 0), b3, voffB);
            PG8_BAR; PG8_WAIT_L(0); PG8_MMA(0, 1, At, B1); PG8_BAR;
            PG8_LDA(At, 1, 1); PG8_STAGE(PG8_SA(1, 0), a3, voffA);
            PG8_BAR; PG8_WAIT_L(0); PG8_MMA(1, 0, At, B0); PG8_BAR; PG8_SCHED;
            PG8_STAGE(PG8_SB(1, 1), b3 + hstep, voffB);
            PG8_WAIT_V(6); PG8_BAR; PG8_MMA(1, 1, At, B1); PG8_BAR;
            }
        }
        if constexpr (ALIGN_EPI) { if (wr == 0) PG8_BAR; }
        if constexpr (!Epi::AFTER_DRAIN) { E(acc, cur, wr, wc, fr, fq); S.done(cur); }
        if (!has_next) break;
#pragma unroll
        for (int a = 0; a < 2; ++a)
#pragma unroll
            for (int b = 0; b < 2; ++b)
#pragma unroll
                for (int m = 0; m < 4; ++m)
#pragma unroll
                    for (int n = 0; n < 2; ++n) acc[a][b][m][n] = (f32x4){0.f, 0.f, 0.f, 0.f};
        cur = nxt; cA = nA; cB = nB; ++ui;
        if constexpr (ALIGN_EPI) { if (wr == 1) PG8_BAR; }
    }
    PG8_WAIT_V(0);
    if constexpr (!ALIGN_EPI) { if (wr == 0) PG8_BAR; }
    PG8_BAR;
#undef PG8_SA
#undef PG8_SB
#undef PG8_STAGE
#undef PG8_LDA
#undef PG8_LDB
#undef PG8_MMA
#undef PG8_WAIT_V
#undef PG8_WAIT_L
#undef PG8_BAR
#undef PG8_SCHED
}
}

#define RLX_AGENT __ATOMIC_RELAXED, __HIP_MEMORY_SCOPE_AGENT
#define LDS_WAIT() asm volatile("s_waitcnt lgkmcnt(0)" ::: "memory")
__device__ __forceinline__ unsigned f2bf(float f) { unsigned u = __builtin_bit_cast(unsigned, f); return (u + 0x7fffu + ((u >> 16) & 1u)) >> 16; }
__device__ __forceinline__ unsigned pk2(float lo, float hi) { return f2bf(lo) | (f2bf(hi) << 16); }
__device__ __forceinline__ float bflo(unsigned w) { return __builtin_bit_cast(float, w << 16); }
__device__ __forceinline__ float bfhi(unsigned w) { return __builtin_bit_cast(float, w & 0xffff0000u); }
__device__ __forceinline__ float ex2(float x) { return __builtin_amdgcn_exp2f(x); }
__device__ __forceinline__ float wave_sum(float v) {
#pragma unroll
    for (int o = 1; o < 64; o <<= 1) v += __shfl_xor(v, o);
    return v;
}

#define XB_TMO      128
#define XB_XCNT(j)  (256  + 64 * (j))
#define XB_XSUB(j)  (1280 + 64 * (j))
#define XB_XGEN(j)  (2304 + 64 * (j))
#define XB_TOP      3328
#define XB_TOPGEN   3392
#define XCD_BAR_WORDS 3456
#define XB_SPIN_CAP (1u << 18)
__device__ __forceinline__ unsigned xb_ld(unsigned* p)              { return __hip_atomic_load(p, __ATOMIC_RELAXED, __HIP_MEMORY_SCOPE_AGENT); }
__device__ __forceinline__ unsigned xb_add(unsigned* p, unsigned v) { return __hip_atomic_fetch_add(p, v, __ATOMIC_RELAXED, __HIP_MEMORY_SCOPE_AGENT); }
__device__ __forceinline__ unsigned xb_xcc_id() { return (unsigned)__builtin_amdgcn_s_getreg((3 << 11) | 20) & 0xFu; }
#define XB_SPIN(cond, bar) do { unsigned _sp = 0; while (cond) { __builtin_amdgcn_s_sleep(1); \
    if ((++_sp & 255u) == 0u) { if (xb_ld(&(bar)[XB_TMO])) break; if (_sp > XB_SPIN_CAP) { atomicAdd(&(bar)[XB_TMO], 1u); break; } } } } while (0)
struct XcdBarrier { unsigned* bar; unsigned x; volatile LAS unsigned* st; };
__device__ __forceinline__ XcdBarrier xcd_barrier_post(unsigned* bar, volatile LAS unsigned* st) {
    XcdBarrier b; b.bar = bar; b.x = xb_xcc_id(); b.st = st;
    if (threadIdx.x == 0) (void)xb_add(&bar[XB_XCNT(b.x)], 1u);
    return b;
}
__device__ __forceinline__ void xcd_barrier_complete(unsigned* bar, unsigned x, unsigned& nloc, unsigned& nx) {
    const unsigned G = gridDim.x * gridDim.y * gridDim.z;
    unsigned sum, cnt, mine, sp = 0u;
    for (;;) {
        sum = 0u; cnt = 0u; mine = 0u;
#pragma unroll
        for (unsigned j = 0; j < 16; ++j) { const unsigned c = xb_ld(&bar[XB_XCNT(j)]); sum += c; cnt += (c > 0u) ? 1u : 0u; mine = (j == x) ? c : mine; }
        if (sum == G) break;
        __builtin_amdgcn_s_sleep(1);
        if ((++sp & 255u) == 0u) { if (xb_ld(&bar[XB_TMO])) break; if (sp > XB_SPIN_CAP) { atomicAdd(&bar[XB_TMO], 1u); break; } }
    }
    nloc = mine > 0u ? mine : 1u; nx = cnt > 0u ? cnt : 1u;
}
__device__ __forceinline__ void xcd_barrier(const XcdBarrier& b) {
    asm volatile("s_waitcnt vmcnt(0)" ::: "memory");
    __syncthreads();
    if (threadIdx.x == 0) {
        unsigned* bar = b.bar;
        __builtin_amdgcn_s_waitcnt(0);
        unsigned nloc = b.st[0], nx = b.st[1];
        if (nloc == 0u) { xcd_barrier_complete(bar, b.x, nloc, nx); b.st[0] = nloc; b.st[1] = nx; }
        const unsigned old = xb_add(&bar[XB_XSUB(b.x)], 1u);
        const unsigned gen = old / nloc;
        if (old + 1u == (gen + 1u) * nloc) {
            __builtin_amdgcn_fence(__ATOMIC_RELEASE, "agent");
            asm volatile("s_waitcnt vmcnt(0)" ::: "memory");
            const unsigned og = xb_add(&bar[XB_TOP], 1u);
            const unsigned tg = og / nx;
            if (og + 1u == (tg + 1u) * nx) xb_add(&bar[XB_TOPGEN], 1u);
            else XB_SPIN(xb_ld(&bar[XB_TOPGEN]) == tg, bar);
            __builtin_amdgcn_fence(__ATOMIC_ACQUIRE, "agent");
            xb_add(&bar[XB_XGEN(b.x)], 1u);
            asm volatile("s_waitcnt vmcnt(0)" ::: "memory");
        } else {
            XB_SPIN(xb_ld(&bar[XB_XGEN(b.x)]) == gen, bar);
            __builtin_amdgcn_fence(__ATOMIC_ACQUIRE, "agent");
            asm volatile("s_waitcnt vmcnt(0)" ::: "memory");
        }
    }
    __syncthreads();
}

struct Ctx { LAS unsigned char* lds; int tid, lane, wave, vcu, G; };

__host__ __device__ __forceinline__ int perm5(int n) { return 8 * ((n >> 2) & 3) + 4 * ((n >> 4) & 1) + (n & 3); }
template <bool PERMN, bool PERMK>
__device__ __forceinline__ void p0_transpose_item(const float* W, int ldw, bf16_t* WT, int kdst, int k0, int n_src0, int drow0, LAS float* scr, int lane) {
#pragma unroll 8
    for (int i = 0; i < 32; ++i) { const int kk = 2 * i + (lane >> 5); scr[kk * 33 + (lane & 31)] = __builtin_nontemporal_load(W + (size_t)(k0 + kk) * ldw + n_src0 + (lane & 31)); }
    LDS_WAIT(); asm volatile("" ::: "memory");
    const int c = lane & 7;
#pragma unroll
    for (int j = 0; j < 4; ++j) { const int n = (lane >> 3) + 8 * j;
        float v[8];
#pragma unroll
        for (int e = 0; e < 8; ++e) { const int kk = PERMK ? (32 * (c >> 2) + 16 * (e >> 2) + 4 * (c & 3) + (e & 3)) : (8 * c + e); v[e] = scr[kk * 33 + n]; }
        u32x4 o; o.x = pk2(v[0], v[1]); o.y = pk2(v[2], v[3]); o.z = pk2(v[4], v[5]); o.w = pk2(v[6], v[7]);
        *(GAS u32x4*)(WT + (size_t)(drow0 + (PERMN ? perm5(n) : n)) * kdst + k0 + 8 * c) = o; }
    LDS_WAIT(); asm volatile("" ::: "memory");
}

struct P0Args { const float *c, *w_ada, *w_in, *pool_w, *pool_scale, *w_out, *w_gate, *w_up, *w_down; bf16_t *WinT, *WoT, *WguT, *WdT; float *modp, *cosT, *sinT; };

__device__ __forceinline__ void p0_prologue(const Ctx& F, const P0Args& A) {
    const int tid = F.tid, lane = F.lane, w = F.wave;
    {
        LAS float* cact = (LAS float*)(F.lds);
        LAS float* red = (LAS float*)(F.lds + 12288);
        constexpr int NIT = 48 * ADA_KC;
        f32x4 wv[16], wvn[16];
        if (F.vcu < NIT) { const int cg = F.vcu % 48, kc = F.vcu / 48; const float* wp = A.w_ada + (size_t)(kc * 128 + w * 16) * NMODW + cg * 256 + lane * 4;
#pragma unroll
            for (int r = 0; r < 16; ++r) wv[r] = __builtin_nontemporal_load((const f32x4*)(wp + (size_t)r * NMODW)); }
        { int slot = 0;
          for (int it = F.vcu; it < NIT && slot < 3; it += F.G, ++slot) { const int kc = it / 48;
              for (int i = tid; i < 1024; i += 512) { const int kk = i >> 3, bb = i & 7; const float cv = A.c[bb * DM + kc * 128 + kk]; cact[slot * 1024 + kk * 8 + bb] = cv / (1.0f + __expf(-cv)); } } }
        __syncthreads();
        int slot = 0;
        for (int it = F.vcu; it < NIT; it += F.G, ++slot) {
            const int cg = it % 48, kc = it / 48;
            if (it + F.G < NIT) { const int itn = it + F.G, cgn = itn % 48, kcn = itn / 48; const float* wp = A.w_ada + (size_t)(kcn * 128 + w * 16) * NMODW + cgn * 256 + lane * 4;
#pragma unroll
                for (int r = 0; r < 16; ++r) wvn[r] = __builtin_nontemporal_load((const f32x4*)(wp + (size_t)r * NMODW)); }
            f32x4 acc[8];
#pragma unroll
            for (int bb = 0; bb < 8; ++bb) acc[bb] = (f32x4){0.f, 0.f, 0.f, 0.f};
            const LAS float* ca_ = cact + (slot % 3) * 1024;
#pragma unroll
            for (int r = 0; r < 16; ++r) {
                const f32x4 ca = *(const LAS f32x4*)(ca_ + (w * 16 + r) * 8), cb = *(const LAS f32x4*)(ca_ + (w * 16 + r) * 8 + 4);
                acc[0] += ca[0] * wv[r]; acc[1] += ca[1] * wv[r]; acc[2] += ca[2] * wv[r]; acc[3] += ca[3] * wv[r];
                acc[4] += cb[0] * wv[r]; acc[5] += cb[1] * wv[r]; acc[6] += cb[2] * wv[r]; acc[7] += cb[3] * wv[r];
            }
#pragma unroll
            for (int bb = 0; bb < 8; ++bb) *(LAS f32x4*)(red + (w * 8 + bb) * 256 + lane * 4) = acc[bb];
            __syncthreads();
            { const int bb = tid >> 6, col = (tid & 63) * 4; f32x4 sm = (f32x4){0.f, 0.f, 0.f, 0.f};
#pragma unroll
              for (int ww = 0; ww < 8; ++ww) sm += *(const LAS f32x4*)(red + (ww * 8 + bb) * 256 + col);
              *(f32x4*)(A.modp + (size_t)(kc * 8 + bb) * NMODW + cg * 256 + col) = sm; }
            __syncthreads();
#pragma unroll
            for (int r = 0; r < 16; ++r) wv[r] = wvn[r];
        }
    }
    {
        const int fr = lane & 15, g4 = lane >> 4;
        for (int u = F.vcu; u < 256; u += F.G) {
            const int g = u >> 6, k0 = (u & 63) * 32;
            f32x4 acc[2][2];
#pragma unroll
            for (int kt = 0; kt < 2; ++kt)
#pragma unroll
                for (int nt = 0; nt < 2; ++nt) acc[kt][nt] = (f32x4){0.f, 0.f, 0.f, 0.f};
            const float* ap = A.w_in + (size_t)(k0 + fr) * INW + g * 256 + 8 * g4;
            const float* bp = A.pool_w + (size_t)(g * 256 + 8 * g4) * 256 + 32 * w + fr;
#pragma unroll 2
            for (int s = 0; s < 8; ++s) {
                bf16x8 af[2], bq[2];
#pragma unroll
                for (int kt = 0; kt < 2; ++kt) { const f32x4 a0 = *(const f32x4*)(ap + (size_t)(16 * kt) * INW + 32 * s), a1 = *(const f32x4*)(ap + (size_t)(16 * kt) * INW + 32 * s + 4);
                    u32x4 t; t.x = pk2(a0[0], a0[1]); t.y = pk2(a0[2], a0[3]); t.z = pk2(a1[0], a1[1]); t.w = pk2(a1[2], a1[3]); af[kt] = __builtin_bit_cast(bf16x8, t); }
#pragma unroll
                for (int nt = 0; nt < 2; ++nt) { float bv[8];
#pragma unroll
                    for (int e = 0; e < 8; ++e) bv[e] = bp[(size_t)(32 * s + e) * 256 + 16 * nt];
                    u32x4 t; t.x = pk2(bv[0], bv[1]); t.y = pk2(bv[2], bv[3]); t.z = pk2(bv[4], bv[5]); t.w = pk2(bv[6], bv[7]); bq[nt] = __builtin_bit_cast(bf16x8, t); }
#pragma unroll
                for (int kt = 0; kt < 2; ++kt)
#pragma unroll
                    for (int nt = 0; nt < 2; ++nt) acc[kt][nt] = __builtin_amdgcn_mfma_f32_16x16x32_bf16(af[kt], bq[nt], acc[kt][nt], 0, 0, 0);
            }
#pragma unroll
            for (int nt = 0; nt < 2; ++nt) { const int n = 32 * w + 16 * nt + fr; const float sc = A.pool_scale[g * 256 + n];
#pragma unroll
                for (int kt = 0; kt < 2; ++kt) { u32x2 o; o.x = pk2(acc[kt][nt][0] * sc, acc[kt][nt][1] * sc); o.y = pk2(acc[kt][nt][2] * sc, acc[kt][nt][3] * sc);
                    *(GAS u32x2*)(A.WinT + (size_t)(g * 256 + n) * DM + k0 + 16 * kt + 4 * g4) = o; } }
        }
    }
    for (int idx = F.vcu * 512 + tid; idx < SEQ * 128; idx += F.G * 512) {
        const int pos = idx >> 7, j = idx & 127;
        const float t = (float)j / 127.0f;
        const float inv = ex2(-t * 13.287712379549449f);
        const double ang = (double)((float)pos * inv);
        const double kq = __builtin_rint(ang * 0.63661977236758134308);
        const double r = (ang - kq * 1.57079632679489655800) - kq * 6.12323399573676603587e-17;
        const double r2 = r * r;
        const double sn = r * (1.0 + r2 * (-1.0 / 6 + r2 * (1.0 / 120 + r2 * (-1.0 / 5040 + r2 * (1.0 / 362880 + r2 * (-1.0 / 39916800 + r2 * (1.0 / 6227020800.0)))))));
        const double cs = 1.0 + r2 * (-0.5 + r2 * (1.0 / 24 + r2 * (-1.0 / 720 + r2 * (1.0 / 40320 + r2 * (-1.0 / 3628800 + r2 * (1.0 / 479001600.0 + r2 * (-1.0 / 87178291200.0)))))));
        const int qd = ((int)kq) & 3;
        const double c = (qd == 0) ? cs : (qd == 1) ? -sn : (qd == 2) ? -cs : sn;
        const double s = (qd == 0) ? sn : (qd == 1) ? cs : (qd == 2) ? -sn : -cs;
        A.cosT[idx] = (float)c; A.sinT[idx] = (float)s;
    }
    {
        LAS float* scr = (LAS float*)(F.lds + w * 16384);
        const int gw = F.vcu * 8 + w, NGW = F.G * 8;
        constexpr int I_IN = (DM / 64) * ((INW - POOLW) / 32), I_O = (DM / 64) * (DM / 32), I_G = (DM / 64) * (FF / 32), I_D = (FF / 64) * (DM / 32);
        constexpr int NITEMS = I_IN + I_O + 2 * I_G + I_D;
        for (int it = gw; it < NITEMS; it += NGW) {
            int r = it;
            if (r < I_IN) { const int nblk = (INW - POOLW) / 32, kb = r / nblk, nb = r % nblk; if (nb >= 96) p0_transpose_item<true, false>(A.w_in + POOLW, INW, A.WinT, DM, kb * 64, nb * 32, POOLW + nb * 32, scr, lane); else p0_transpose_item<false, false>(A.w_in + POOLW, INW, A.WinT, DM, kb * 64, nb * 32, POOLW + nb * 32, scr, lane); continue; } r -= I_IN;
            if (r < I_O) { const int nblk = DM / 32, kb = r / nblk, nb = r % nblk; if (kb >= 16) p0_transpose_item<false, true>(A.w_out, DM, A.WoT, DM, kb * 64, nb * 32, nb * 32, scr, lane); else p0_transpose_item<false, false>(A.w_out, DM, A.WoT, DM, kb * 64, nb * 32, nb * 32, scr, lane); continue; } r -= I_O;
            if (r < I_G) { const int nblk = FF / 32, kb = r / nblk, nb = r % nblk; p0_transpose_item<false, false>(A.w_gate, FF, A.WguT, DM, kb * 64, nb * 32, 256 * (nb >> 2) + 32 * (nb & 3), scr, lane); continue; } r -= I_G;
            if (r < I_G) { const int nblk = FF / 32, kb = r / nblk, nb = r % nblk; p0_transpose_item<false, false>(A.w_up, FF, A.WguT, DM, kb * 64, nb * 32, 256 * (nb >> 2) + 128 + 32 * (nb & 3), scr, lane); continue; } r -= I_G;
            { const int nblk = DM / 32, kb = r / nblk, nb = r % nblk; p0_transpose_item<false, false>(A.w_down, DM, A.WdT, FF, kb * 64, nb * 32, nb * 32, scr, lane); }
        }
    }
}

template <int MODE>
__device__ __forceinline__ void norm_mod_phase(const Ctx& F, const float* src, bf16_t* dst, const float* gnorm, const float* modp, const float* b_ada, float* mod, int sh_idx, int sc_idx) {
    LAS float* Av = (LAS float*)(F.lds); LAS float* Bv = (LAS float*)(F.lds + 8192);
    for (int blk = F.vcu; blk < MTOK / 64; blk += F.G) {
        const int b = blk >> 5;
        const int row0 = blk * 64 + F.wave * 8;
        f32x4 v[8], vn[8];
        { const GAS f32x4* xr = (const GAS f32x4*)(src + (size_t)row0 * DM) + F.lane;
#pragma unroll
          for (int j = 0; j < 8; ++j) v[j] = __builtin_nontemporal_load(xr + 64 * j); }
        __syncthreads();
        for (int k = F.tid; k < DM; k += 512) {
            float sc, sh;
            if (MODE == 0) {
                sc = b_ada[sc_idx * DM + k]; sh = b_ada[sh_idx * DM + k];
#pragma unroll 4
                for (int kc = 0; kc < ADA_KC; ++kc) { sc += modp[(size_t)(kc * 8 + b) * NMODW + sc_idx * DM + k]; sh += modp[(size_t)(kc * 8 + b) * NMODW + sh_idx * DM + k]; }
            } else { sc = mod[(size_t)b * NMODW + sc_idx * DM + k]; sh = mod[(size_t)b * NMODW + sh_idx * DM + k]; }
            Av[k] = gnorm[k] * (1.0f + sc); Bv[k] = sh;
        }
        if (MODE == 0) {
            if (F.tid < 384) { const int idx = blk * 384 + F.tid, bb = idx / NMODW, n = idx % NMODW; float s = b_ada[n];
#pragma unroll 4
                for (int kc = 0; kc < ADA_KC; ++kc) s += modp[(size_t)(kc * 8 + bb) * NMODW + n];
                mod[idx] = s; }
        }
        __syncthreads();
        {
            for (int i = 0; i < 8; ++i) {
                const int row = row0 + i;
                if (i < 7) { const GAS f32x4* xr = (const GAS f32x4*)(src + (size_t)(row + 1) * DM) + F.lane;
#pragma unroll
                    for (int j = 0; j < 8; ++j) vn[j] = __builtin_nontemporal_load(xr + 64 * j); }
                float s = 0.f;
#pragma unroll
                for (int j = 0; j < 8; ++j) s += (v[j][0] * v[j][0] + v[j][1] * v[j][1]) + (v[j][2] * v[j][2] + v[j][3] * v[j][3]);
                const float rstd = 1.0f / sqrtf(wave_sum(s) * (1.0f / DM) + EPS);
                GAS u32x2* o8 = (GAS u32x2*)(dst + (size_t)row * DM) + F.lane;
#pragma unroll
                for (int j = 0; j < 8; ++j) { const f32x4 a = *(const LAS f32x4*)(Av + 4 * F.lane + 256 * j), bb = *(const LAS f32x4*)(Bv + 4 * F.lane + 256 * j);
                    const f32x4 o = v[j] * rstd * a + bb; u32x2 wv; wv.x = pk2(o[0], o[1]); wv.y = pk2(o[2], o[3]); o8[64 * j] = wv; }
#pragma unroll
                for (int j = 0; j < 8; ++j) v[j] = vn[j];
            }
        }
    }
}

__device__ __forceinline__ void norm_mod_bf16_phase(const Ctx& F, const bf16_t* src, bf16_t* dst, const float* gnorm, const float* mod, int sh_idx, int sc_idx) {
    LAS float* Av = (LAS float*)(F.lds); LAS float* Bv = (LAS float*)(F.lds + 8192);
    for (int blk = F.vcu; blk < MTOK / 64; blk += F.G) {
        const int b = blk >> 5;
        __syncthreads();
        for (int k = F.tid; k < DM; k += 512) { const float sc = mod[(size_t)b * NMODW + sc_idx * DM + k], sh = mod[(size_t)b * NMODW + sh_idx * DM + k]; Av[k] = gnorm[k] * (1.0f + sc); Bv[k] = sh; }
        __syncthreads();
        const int row0 = blk * 64 + F.wave * 8;
        u32x4 v[4], vn[4];
        { const GAS u32x4* xr = (const GAS u32x4*)(src + (size_t)row0 * DM) + F.lane;
#pragma unroll
          for (int j = 0; j < 4; ++j) v[j] = __builtin_nontemporal_load(xr + 64 * j); }
        for (int i = 0; i < 8; ++i) {
            const int row = row0 + i;
            if (i < 7) { const GAS u32x4* xr = (const GAS u32x4*)(src + (size_t)(row + 1) * DM) + F.lane;
#pragma unroll
                for (int j = 0; j < 4; ++j) vn[j] = __builtin_nontemporal_load(xr + 64 * j); }
            float f[4][8]; float s = 0.f;
#pragma unroll
            for (int j = 0; j < 4; ++j) { f[j][0] = bflo(v[j].x); f[j][1] = bfhi(v[j].x); f[j][2] = bflo(v[j].y); f[j][3] = bfhi(v[j].y); f[j][4] = bflo(v[j].z); f[j][5] = bfhi(v[j].z); f[j][6] = bflo(v[j].w); f[j][7] = bfhi(v[j].w);
#pragma unroll
                for (int e = 0; e < 8; ++e) s += f[j][e] * f[j][e]; }
            const float rstd = 1.0f / sqrtf(wave_sum(s) * (1.0f / DM) + EPS);
            GAS u32x4* o16 = (GAS u32x4*)(dst + (size_t)row * DM) + F.lane;
#pragma unroll
            for (int j = 0; j < 4; ++j) { const LAS float* ap = Av + 8 * F.lane + 512 * j; const LAS float* bp = Bv + 8 * F.lane + 512 * j;
                const f32x4 a0 = *(const LAS f32x4*)ap, a1 = *(const LAS f32x4*)(ap + 4), b0 = *(const LAS f32x4*)bp, b1 = *(const LAS f32x4*)(bp + 4);
                u32x4 w; w.x = pk2(f[j][0] * rstd * a0[0] + b0[0], f[j][1] * rstd * a0[1] + b0[1]); w.y = pk2(f[j][2] * rstd * a0[2] + b0[2], f[j][3] * rstd * a0[3] + b0[3]);
                w.z = pk2(f[j][4] * rstd * a1[0] + b1[0], f[j][5] * rstd * a1[1] + b1[1]); w.w = pk2(f[j][6] * rstd * a1[2] + b1[2], f[j][7] * rstd * a1[3] + b1[3]);
                o16[64 * j] = w; }
#pragma unroll
            for (int j = 0; j < 4; ++j) v[j] = vn[j];
        }
    }
}

__device__ __forceinline__ void final_norm_phase(const Ctx& F, const bf16_t* src, float* out, const float* g) {
    const int gw = F.vcu * 8 + F.wave, NGW = F.G * 8;
    static_assert(MTOK % 2048 == 0, "rows per wave");
    for (int r0 = gw; r0 < MTOK; r0 += NGW * 8) {
        u32x4 v[8][4];
#pragma unroll
        for (int i = 0; i < 8; ++i) { const GAS u32x4* xr = (const GAS u32x4*)(src + (size_t)(r0 + i * NGW) * DM) + F.lane;
#pragma unroll
            for (int j = 0; j < 4; ++j) v[i][j] = (r0 + i * NGW < MTOK) ? xr[64 * j] : (u32x4){0u, 0u, 0u, 0u}; }
#pragma unroll
        for (int i = 0; i < 8; ++i) {
            const int row = r0 + i * NGW;
            if (row < MTOK) {
                float f[4][8]; float s = 0.f;
#pragma unroll
                for (int j = 0; j < 4; ++j) { f[j][0] = bflo(v[i][j].x); f[j][1] = bfhi(v[i][j].x); f[j][2] = bflo(v[i][j].y); f[j][3] = bfhi(v[i][j].y); f[j][4] = bflo(v[i][j].z); f[j][5] = bfhi(v[i][j].z); f[j][6] = bflo(v[i][j].w); f[j][7] = bfhi(v[i][j].w);
#pragma unroll
                    for (int e = 0; e < 8; ++e) s += f[j][e] * f[j][e]; }
                const float rstd = 1.0f / sqrtf(wave_sum(s) * (1.0f / DM) + EPS);
                float* orow = out + (size_t)row * DM + 8 * F.lane;
#pragma unroll
                for (int j = 0; j < 4; ++j) { const f32x4 g0 = *(const f32x4*)(g + 8 * F.lane + 512 * j), g1 = *(const f32x4*)(g + 8 * F.lane + 512 * j + 4);
                    f32x4 o0, o1;
#pragma unroll
                    for (int e = 0; e < 4; ++e) { o0[e] = f[j][e] * rstd * g0[e]; o1[e] = f[j][4 + e] * rstd * g1[e]; }
                    *(f32x4*)(orow + 512 * j) = o0; *(f32x4*)(orow + 512 * j + 4) = o1; }
            }
        }
    }
}

__device__ __forceinline__ void pool_phase(const Ctx& F, const bf16_t* proj, bf16_t* cat) {
    LAS unsigned char* T = F.lds;
    for (int blk = F.vcu; blk < MTOK / 64; blk += F.G) {
        const int b = blk >> 5, tb = (blk & 31) * 64;
        for (int hc = 0; hc < 2; ++hc) {
            int tid = F.tid; asm volatile("" : "+v"(tid));
            __syncthreads();
            { u32x4 r[10];
#pragma unroll
              for (int i = 0; i < 10; ++i) { const int idx = tid + 512 * i, row = idx >> 6, chn = idx & 63, gt = tb - 8 + row;
                  r[i] = (u32x4){0u, 0u, 0u, 0u};
                  if (gt >= 0 && gt < SEQ) r[i] = __builtin_nontemporal_load((const u32x4*)(proj + ((size_t)b * SEQ + gt) * INW + hc * 512 + chn * 8)); }
#pragma unroll
              for (int i = 0; i < 10; ++i) { const int idx = tid + 512 * i; *(LAS u32x4*)(T + idx * 16) = r[i]; } }
            __syncthreads();
            const int cgl = tid & 63, rg = tid >> 6;
            const int half = 1 << (hc * 2 + (cgl >> 5));
            const int t0 = tb + rg * 8;
            LAS unsigned char* col = T + cgl * 16;
            float S[8];
#pragma unroll
            for (int e = 0; e < 8; ++e) S[e] = 0.f;
            { const int lo = (t0 - half) > 0 ? (t0 - half) : 0, hi = (t0 + half) < SEQ ? (t0 + half) : SEQ;
              for (int j = lo; j < hi; ++j) { const u32x4 v = *(const LAS u32x4*)(col + (j - tb + 8) * 1024);
                  S[0] += bflo(v.x); S[1] += bfhi(v.x); S[2] += bflo(v.y); S[3] += bfhi(v.y); S[4] += bflo(v.z); S[5] += bfhi(v.z); S[6] += bflo(v.w); S[7] += bfhi(v.w); } }
#pragma unroll
            for (int i = 0; i < 8; ++i) {
                const int t = t0 + i;
                const int lo = (t - half) > 0 ? (t - half) : 0, hi = (t + half) < SEQ ? (t + half) : SEQ;
                const float rc = 1.0f / (float)(hi - lo);
                const u32x4 v = *(const LAS u32x4*)(col + (t - tb + 8) * 1024);
                u32x4 o;
                o.x = pk2(S[0] * rc - bflo(v.x), S[1] * rc - bfhi(v.x)); o.y = pk2(S[2] * rc - bflo(v.y), S[3] * rc - bfhi(v.y));
                o.z = pk2(S[4] * rc - bflo(v.z), S[5] * rc - bfhi(v.z)); o.w = pk2(S[6] * rc - bflo(v.w), S[7] * rc - bfhi(v.w));
                *(u32x4*)(cat + ((size_t)b * SEQ + t) * DM + hc * 512 + cgl * 8) = o;
                if (t + half < SEQ) { const u32x4 a = *(const LAS u32x4*)(col + (t + half - tb + 8) * 1024);
                    S[0] += bflo(a.x); S[1] += bfhi(a.x); S[2] += bflo(a.y); S[3] += bfhi(a.y); S[4] += bflo(a.z); S[5] += bfhi(a.z); S[6] += bflo(a.w); S[7] += bfhi(a.w); }
                if (t - half >= 0) { const u32x4 a = *(const LAS u32x4*)(col + (t - half - tb + 8) * 1024);
                    S[0] -= bflo(a.x); S[1] -= bfhi(a.x); S[2] -= bflo(a.y); S[3] -= bfhi(a.y); S[4] -= bflo(a.z); S[5] -= bfhi(a.z); S[6] -= bflo(a.w); S[7] -= bfhi(a.w); }
            }
        }
    }
    __syncthreads();
}

constexpr int RS = 544;
constexpr int RSV = 160;
__device__ __forceinline__ bf16x8 tr_pair(LAS unsigned char* p0, LAS unsigned char* p1) {
    const s16x4 a = __builtin_amdgcn_ds_read_tr16_b64_v4i16((LAS s16x4*)p0), b = __builtin_amdgcn_ds_read_tr16_b64_v4i16((LAS s16x4*)p1);
    return __builtin_shufflevector(a, b, 0, 1, 2, 3, 4, 5, 6, 7);
}
__device__ __forceinline__ bf16x8 pack8(const f32x4 a, const f32x4 b) {
    u32x4 w; w.x = pk2(a[0], a[1]); w.y = pk2(a[2], a[3]); w.z = pk2(b[0], b[1]); w.w = pk2(b[2], b[3]);
    return __builtin_bit_cast(bf16x8, w);
}

__device__ __forceinline__ void ret_chain_phase(const Ctx& F, const bf16_t* proj, bf16_t* yp, const float* dec_f, const float* dec_b) {
    LAS unsigned char* KT = F.lds; LAS unsigned char* VT = F.lds + 128 * RS; LAS unsigned char* ST = F.lds + 128 * RS + 128 * RSV;
    const int w = F.wave;
    for (int ch = F.vcu; ch < 256; ch += F.G) {
        int tid = F.tid; asm volatile("" : "+v"(tid));
        const int lane = tid & 63, fr = lane & 15, g4 = lane >> 4, q = fr >> 2, p = fr & 3;
        const int bh = ch >> 3, b = bh >> 2, h = bh & 3, dir = (ch >> 2) & 1, slab = ch & 3;
        const float lg = -__expf(dir ? dec_b[h] : dec_f[h]);
        const float l2 = lg * 1.44269504088896341f;
        f32x4 S[2][4];
#pragma unroll
        for (int dd = 0; dd < 2; ++dd)
#pragma unroll
            for (int et = 0; et < 4; ++et) S[dd][et] = (f32x4){0.f, 0.f, 0.f, 0.f};
        __syncthreads();
        for (int i = tid; i < 64 * RS / 16; i += 512) *(LAS u32x4*)(ST + i * 16) = (u32x4){0u, 0u, 0u, 0u};
        const float cdec = ex2(128.0f * l2);
        const int krow = tid >> 5, kc16 = tid & 31, vrow = tid >> 3, vc16 = tid & 7;
        u32x4 kreg[8], vreg[2]; bf16x8 qreg[8];
#define RC_PTRS(STEP) const int n_ = dir ? (NCHK - 1 - (STEP)) : (STEP); const size_t mm = (size_t)b * SEQ + (size_t)n_ * CHK; \
            const bf16_t* kp_ = proj + (mm + krow) * INW + 2048 + 256 * h + kc16 * 8; \
            const bf16_t* vp_ = proj + (mm + vrow) * INW + 3072 + 256 * h + 64 * slab + vc16 * 8; \
            const bf16_t* qp_ = proj + (mm + 16 * w + fr) * INW + 1024 + 256 * h + 8 * g4;
#define RC_LOAD_K(I0) do { kreg[(I0)] = *(const u32x4*)(kp_ + (size_t)(16 * (I0)) * INW); kreg[(I0) + 1] = *(const u32x4*)(kp_ + (size_t)(16 * ((I0) + 1)) * INW); } while (0)
#define RC_LOAD_Q(S0) do { qreg[(S0)] = *(const bf16x8*)(qp_ + 32 * (S0)); qreg[(S0) + 1] = *(const bf16x8*)(qp_ + 32 * ((S0) + 1)); } while (0)
#define RC_LOAD_V() do { vreg[0] = *(const u32x4*)(vp_); vreg[1] = *(const u32x4*)(vp_ + (size_t)64 * INW); } while (0)
        { RC_PTRS(0); RC_LOAD_K(0); RC_LOAD_K(2); RC_LOAD_K(4); RC_LOAD_K(6); RC_LOAD_V(); RC_LOAD_Q(0); RC_LOAD_Q(2); RC_LOAD_Q(4); RC_LOAD_Q(6); }
        for (int step = 0; step < NCHK; ++step) {
            const int n = dir ? (NCHK - 1 - step) : step;
            const size_t m0 = (size_t)b * SEQ + (size_t)n * CHK;
#pragma unroll
            for (int i = 0; i < 8; ++i) *(LAS u32x4*)(KT + (krow + 16 * i) * RS + kc16 * 16) = kreg[i];
#pragma unroll
            for (int i = 0; i < 2; ++i) { const int row = vrow + 64 * i; const u32x4 v = vreg[i];
                const float kd = ex2((float)(dir ? row : (CHK - 1 - row)) * l2);
                u32x4 o; o.x = pk2(bflo(v.x) * kd, bfhi(v.x) * kd); o.y = pk2(bflo(v.y) * kd, bfhi(v.y) * kd); o.z = pk2(bflo(v.z) * kd, bfhi(v.z) * kd); o.w = pk2(bflo(v.w) * kd, bfhi(v.w) * kd);
                *(LAS u32x4*)(VT + row * RSV + vc16 * 16) = o; }
            bf16x8 qf[8];
#pragma unroll
            for (int s = 0; s < 8; ++s) qf[s] = qreg[s];
            __syncthreads();
            const bool more = step + 1 < NCHK;
            RC_PTRS(more ? step + 1 : step);
            { f32x4 y[4];
              bf16x8 sfb[2][8];
#pragma unroll
              for (int s = 0; s < 8; ++s) sfb[0][s] = *(const LAS bf16x8*)(ST + (fr) * RS + (32 * s + 8 * g4) * 2);
#pragma unroll
              for (int et = 0; et < 4; ++et) { y[et] = (f32x4){0.f, 0.f, 0.f, 0.f};
                  if (et < 3) {
#pragma unroll
                      for (int s = 0; s < 8; ++s) sfb[(et + 1) & 1][s] = *(const LAS bf16x8*)(ST + (16 * (et + 1) + fr) * RS + (32 * s + 8 * g4) * 2); }
#pragma unroll
                  for (int s = 0; s < 8; ++s) y[et] = __builtin_amdgcn_mfma_f32_16x16x32_bf16(sfb[et & 1][s], qf[s], y[et], 0, 0, 0);
                  if (more) RC_LOAD_K(2 * et);
                  __builtin_amdgcn_sched_barrier(0); }
              const int ii = 16 * w + fr;
              const float a = ex2((float)(dir ? (CHK - ii) : (ii + 1)) * l2);
              bf16_t* yo = yp + ((size_t)dir * MTOK + m0 + ii) * 1024 + 256 * h + 64 * slab + 8 * g4;
#pragma unroll
              for (int jp = 0; jp < 2; ++jp) { u32x4 o; o.x = pk2(y[2 * jp][0] * a, y[2 * jp][1] * a); o.y = pk2(y[2 * jp][2] * a, y[2 * jp][3] * a);
                  o.z = pk2(y[2 * jp + 1][0] * a, y[2 * jp + 1][1] * a); o.w = pk2(y[2 * jp + 1][2] * a, y[2 * jp + 1][3] * a); *(u32x4*)(yo + 32 * jp) = o; } }
            if (step < NCHK - 1) {
#pragma unroll
                for (int dd = 0; dd < 2; ++dd)
#pragma unroll
                    for (int et = 0; et < 4; ++et) S[dd][et] *= cdec;
                bf16x8 kfb[2][2], vfb[2][4];
#define RC_FRAGS(BUF, SS) do { _Pragma("unroll") for (int dd = 0; dd < 2; ++dd) { LAS unsigned char* a0 = KT + (32 * (SS) + 8 * g4 + q) * RS + (32 * w + 16 * dd + 4 * p) * 2; kfb[BUF][dd] = tr_pair(a0, a0 + 4 * RS); } \
                    _Pragma("unroll") for (int et = 0; et < 4; ++et) { LAS unsigned char* b0 = VT + (32 * (SS) + 8 * g4 + q) * RSV + (16 * et + 4 * p) * 2; vfb[BUF][et] = tr_pair(b0, b0 + 4 * RSV); } } while (0)
                RC_FRAGS(0, 0);
#pragma unroll
                for (int s = 0; s < 4; ++s) {
                    if (s < 3) RC_FRAGS((s + 1) & 1, s + 1);
#pragma unroll
                    for (int dd = 0; dd < 2; ++dd)
#pragma unroll
                        for (int et = 0; et < 4; ++et) S[dd][et] = __builtin_amdgcn_mfma_f32_16x16x32_bf16(kfb[s & 1][dd], vfb[s & 1][et], S[dd][et], 0, 0, 0);
                    RC_LOAD_Q(2 * s); if (s == 0) RC_LOAD_V();
                    __builtin_amdgcn_sched_barrier(0);
                }
#undef RC_FRAGS
            }
            __syncthreads();
            if (step < NCHK - 1) {
#pragma unroll
                for (int dd = 0; dd < 2; ++dd)
#pragma unroll
                    for (int et = 0; et < 4; ++et) { u32x2 o; o.x = pk2(S[dd][et][0], S[dd][et][1]); o.y = pk2(S[dd][et][2], S[dd][et][3]);
                        *(LAS u32x2*)(ST + (16 * et + fr) * RS + (32 * w + 16 * dd + 4 * g4) * 2) = o; }
            }
        }
#undef RC_PTRS
#undef RC_LOAD_K
#undef RC_LOAD_Q
#undef RC_LOAD_V
    }
}

__device__ __forceinline__ void ret_out_phase(const Ctx& F, const bf16_t* proj, const bf16_t* yp, bf16_t* cat, const float* dec_f, const float* dec_b) {
    LAS unsigned char* KT = F.lds; LAS unsigned char* VT = F.lds + 128 * RS;
    const int tid_ = F.tid, w = F.wave;
    for (int u = F.vcu; u < BATCH * NHEAD * NCHK; u += F.G) {
        const int bh = u >> 4, b = bh >> 2, h = bh & 3, n = u & 15;
        const size_t m0 = (size_t)b * SEQ + (size_t)n * CHK;
        const float lf2 = -__expf(dec_f[h]) * 1.44269504088896341f, lb2 = -__expf(dec_b[h]) * 1.44269504088896341f;
        int tid = tid_; asm volatile("" : "+v"(tid));
        const int lane = tid & 63, fr = lane & 15, g4 = lane >> 4, q = fr >> 2, p = fr & 3;
        const size_t m = m0 + 16 * w + fr;
        bf16x8 qf[8];
        { u32x4 kreg[8], vreg[8];
          const int row = tid >> 5, c16 = tid & 31;
          const bf16_t* kp = proj + (m0 + row) * INW + 2048 + 256 * h + c16 * 8; const bf16_t* vp = kp + 1024;
#pragma unroll
          for (int i = 0; i < 8; ++i) kreg[i] = __builtin_nontemporal_load((const u32x4*)(kp + (size_t)(16 * i) * INW));
#pragma unroll
          for (int i = 0; i < 8; ++i) vreg[i] = __builtin_nontemporal_load((const u32x4*)(vp + (size_t)(16 * i) * INW));
          const bf16_t* qp = proj + m * INW + 1024 + 256 * h + 8 * g4;
#pragma unroll
          for (int s = 0; s < 8; ++s) qf[s] = __builtin_nontemporal_load((const bf16x8*)(qp + 32 * s));
          __syncthreads();
#pragma unroll
          for (int i = 0; i < 8; ++i) *(LAS u32x4*)(KT + (row + 16 * i) * RS + c16 * 16) = kreg[i];
#pragma unroll
          for (int i = 0; i < 8; ++i) *(LAS u32x4*)(VT + (row + 16 * i) * RS + c16 * 16) = vreg[i]; }
        __syncthreads();
        u32x4 yfq[8], ybq[8], gq[8];
        { const bf16_t* yf = yp + m * 1024 + 256 * h + 8 * g4; const bf16_t* yb = yp + ((size_t)MTOK + m) * 1024 + 256 * h + 8 * g4; const bf16_t* gp = proj + m * INW + 4096 + 256 * h + 8 * g4;
#pragma unroll
          for (int j = 0; j < 8; ++j) { yfq[j] = *(const u32x4*)(yf + 32 * j); ybq[j] = *(const u32x4*)(yb + 32 * j); gq[j] = *(const u32x4*)(gp + 32 * j); } }
        bf16x8 pb[4];
        {
            f32x4 pt[8];
            bf16x8 kfb[2][8];
#pragma unroll
            for (int s = 0; s < 8; ++s) kfb[0][s] = *(const LAS bf16x8*)(KT + (fr) * RS + (32 * s + 8 * g4) * 2);
#pragma unroll
            for (int jt = 0; jt < 8; ++jt) { pt[jt] = (f32x4){0.f, 0.f, 0.f, 0.f};
                if (jt < 7) {
#pragma unroll
                    for (int s = 0; s < 8; ++s) kfb[(jt + 1) & 1][s] = *(const LAS bf16x8*)(KT + (16 * (jt + 1) + fr) * RS + (32 * s + 8 * g4) * 2); }
#pragma unroll
                for (int s = 0; s < 8; ++s) pt[jt] = __builtin_amdgcn_mfma_f32_16x16x32_bf16(kfb[jt & 1][s], qf[s], pt[jt], 0, 0, 0);
                __builtin_amdgcn_sched_barrier(0); }
            const int il = 16 * w + fr;
#pragma unroll
            for (int jt = 0; jt < 8; ++jt)
#pragma unroll
                for (int r = 0; r < 4; ++r) { const int df = il - (16 * jt + 4 * g4 + r);
                    const float dcy = df >= 0 ? ex2((float)df * lf2) : ex2((float)(-df) * lb2);
                    pt[jt][r] *= dcy; }
#pragma unroll
            for (int s = 0; s < 4; ++s) pb[s] = pack8(pt[2 * s], pt[2 * s + 1]);
        }
        f32x4 ot[16];
#pragma unroll
        for (int et = 0; et < 16; ++et) ot[et] = (f32x4){0.f, 0.f, 0.f, 0.f};
        {
            bf16x8 vfb[2][8];
#define RO_FRAGS(BUF, B8) do { _Pragma("unroll") for (int e8 = 0; e8 < 8; ++e8) { LAS unsigned char* a0 = VT + (32 * ((B8) >> 1) + 4 * g4 + q) * RS + (16 * (8 * ((B8) & 1) + e8) + 4 * p) * 2; vfb[BUF][e8] = tr_pair(a0, a0 + 16 * RS); } } while (0)
            RO_FRAGS(0, 0);
#pragma unroll
            for (int b8 = 0; b8 < 8; ++b8) {
                if (b8 < 7) RO_FRAGS((b8 + 1) & 1, b8 + 1);
#pragma unroll
                for (int e8 = 0; e8 < 8; ++e8) ot[8 * (b8 & 1) + e8] = __builtin_amdgcn_mfma_f32_16x16x32_bf16(vfb[b8 & 1][e8], pb[b8 >> 1], ot[8 * (b8 & 1) + e8], 0, 0, 0);
                __builtin_amdgcn_sched_barrier(0);
            }
#undef RO_FRAGS
        }
        float ss = 0.f;
#pragma unroll
        for (int j = 0; j < 8; ++j) {
            ot[2 * j][0] += bflo(yfq[j].x) + bflo(ybq[j].x); ot[2 * j][1] += bfhi(yfq[j].x) + bfhi(ybq[j].x); ot[2 * j][2] += bflo(yfq[j].y) + bflo(ybq[j].y); ot[2 * j][3] += bfhi(yfq[j].y) + bfhi(ybq[j].y);
            ot[2 * j + 1][0] += bflo(yfq[j].z) + bflo(ybq[j].z); ot[2 * j + 1][1] += bfhi(yfq[j].z) + bfhi(ybq[j].z); ot[2 * j + 1][2] += bflo(yfq[j].w) + bflo(ybq[j].w); ot[2 * j + 1][3] += bfhi(yfq[j].w) + bfhi(ybq[j].w);
#pragma unroll
            for (int t = 0; t < 2; ++t) ss += (ot[2 * j + t][0] * ot[2 * j + t][0] + ot[2 * j + t][1] * ot[2 * j + t][1]) + (ot[2 * j + t][2] * ot[2 * j + t][2] + ot[2 * j + t][3] * ot[2 * j + t][3]); }
        ss += __shfl_xor(ss, 16); ss += __shfl_xor(ss, 32);
        const float rstd = 1.0f / sqrtf(ss * (1.0f / DH) + EPS);
        bf16_t* op = cat + m * DM + 1024 + 256 * h + 8 * g4;
#pragma unroll
        for (int j = 0; j < 8; ++j) {
            u32x4 o;
            o.x = pk2(pg8::fast_silu(bflo(gq[j].x)) * ot[2 * j][0] * rstd, pg8::fast_silu(bfhi(gq[j].x)) * ot[2 * j][1] * rstd);
            o.y = pk2(pg8::fast_silu(bflo(gq[j].y)) * ot[2 * j][2] * rstd, pg8::fast_silu(bfhi(gq[j].y)) * ot[2 * j][3] * rstd);
            o.z = pk2(pg8::fast_silu(bflo(gq[j].z)) * ot[2 * j + 1][0] * rstd, pg8::fast_silu(bfhi(gq[j].z)) * ot[2 * j + 1][1] * rstd);
            o.w = pk2(pg8::fast_silu(bflo(gq[j].w)) * ot[2 * j + 1][2] * rstd, pg8::fast_silu(bfhi(gq[j].w)) * ot[2 * j + 1][3] * rstd);
            *(u32x4*)(op + 32 * j) = o; }
    }
}

constexpr int NPHASE = 10;
struct Args { const float* in[16]; float* out; unsigned char* ws; int ph_lo, ph_hi; };
__global__ void __launch_bounds__(512, 2) fwd_kernel(Args args) {
    extern __shared__ __attribute__((aligned(16))) unsigned char lds_raw[];
    Ctx F;
    F.lds = (LAS unsigned char*)lds_raw;
    F.tid = threadIdx.x; F.lane = F.tid & 63; F.wave = __builtin_amdgcn_readfirstlane(F.tid >> 6);
    F.G = gridDim.x; { const int bx = blockIdx.x; F.vcu = (F.G % 8 == 0) ? (bx % 8) * (F.G / 8) + bx / 8 : bx; }
    unsigned char* ws = args.ws;
    gu32* ctl = (gu32*)(ws + WS_CTL);
    volatile LAS unsigned* MISC = (volatile LAS unsigned*)(F.lds + LDSCTL_OFF);
    for (int u = F.tid; u < (LDS_BYTES - LDSCTL_OFF) / 4; u += 512) ((LAS unsigned*)(F.lds + LDSCTL_OFF))[u] = 0u;
    __syncthreads();
    const int lo = args.ph_lo, hi = args.ph_hi;
    const bool multi = (hi - lo) > 1;
    XcdBarrier bar; bar.bar = (unsigned*)(ctl + CW_BAR); bar.x = 0; bar.st = nullptr;
    if (multi) bar = xcd_barrier_post((unsigned*)(ctl + CW_BAR), MISC + 8);
#ifndef PHASE_MASK
#define PHASE_MASK 0x3ff
#endif
#define IN(k) (((PHASE_MASK >> (k)) & 1) && lo <= (k) && (k) < hi)
#define SEAM(k) do { if (IN(k) && IN((k) + 1)) xcd_barrier(bar); { int t_ = threadIdx.x; asm volatile("" : "+v"(t_)); F.tid = t_; F.lane = t_ & 63; F.wave = __builtin_amdgcn_readfirstlane(t_ >> 6); } } while (0)
    const float* x = args.in[0]; const float* c = args.in[1]; const float* w_ada = args.in[2]; const float* b_ada = args.in[3]; const float* norm1_g = args.in[4];
    const float* w_in = args.in[5]; const float* pool_w = args.in[6]; const float* pool_scale = args.in[7]; const float* dec_f = args.in[8]; const float* dec_b = args.in[9];
    const float* w_out = args.in[10]; const float* norm2_g = args.in[11]; const float* w_gate = args.in[12]; const float* w_up = args.in[13]; const float* w_down = args.in[14]; const float* final_g = args.in[15];
    float* out = args.out;
    bf16_t* WinT = (bf16_t*)(ws + WS_WIN); bf16_t* WoT = (bf16_t*)(ws + WS_WO); bf16_t* WguT = (bf16_t*)(ws + WS_WGU); bf16_t* WdT = (bf16_t*)(ws + WS_WD);
    float* modp = (float*)(ws + WS_MODP); float* mod = (float*)(ws + WS_MOD); float* cosT = (float*)(ws + WS_ROPE); float* sinT = cosT + SEQ * 128;
    bf16_t* H = (bf16_t*)(ws + WS_H); bf16_t* CAT = (bf16_t*)(ws + WS_CAT); bf16_t* PROJ = (bf16_t*)(ws + WS_PROJ); bf16_t* ACT = (bf16_t*)(ws + WS_ACT);
    bf16_t* X1 = (bf16_t*)out;
    bf16_t* X2 = (bf16_t*)(ws + WS_H);

#ifndef REPEAT_MASK
#define REPEAT_MASK 0
#endif
#define REP(k) for (int rep_ = 0; rep_ < 1 + ((REPEAT_MASK >> (k)) & 1); ++rep_)
    if (IN(0)) REP(0) { P0Args A{c, w_ada, w_in, pool_w, pool_scale, w_out, w_gate, w_up, w_down, WinT, WoT, WguT, WdT, modp, cosT, sinT}; p0_prologue(F, A); __syncthreads(); }
    SEAM(0);
    if (IN(1)) REP(1) { norm_mod_phase<0>(F, x, H, norm1_g, modp, b_ada, mod, 0, 1); }
    SEAM(1);
    if (IN(2)) REP(2) { pg8::Gemm g{H, WinT, MTOK, INW, DM}; pg8::StaticOrder S; S.init(MTOK, INW, F.G, (int)blockIdx.x); pg8::EpiProj E{PROJ, cosT, sinT};
        pg8::gemm_phase<pg8::EpiProj, pg8::StaticOrder, true, true>(F.lds, g, S, E); }
    SEAM(2);
    if (IN(3)) REP(3) { pool_phase(F, PROJ, CAT); ret_chain_phase(F, PROJ, (bf16_t*)out, dec_f, dec_b); }
    SEAM(3);
    if (IN(4)) REP(4) { ret_out_phase(F, PROJ, (const bf16_t*)out, CAT, dec_f, dec_b); }
    SEAM(4);
    if (IN(5)) REP(5) { pg8::Gemm g{CAT, WoT, MTOK, DM, DM}; pg8::StaticOrder S; S.init(MTOK, DM, F.G, (int)blockIdx.x); pg8::EpiRes<false> E{x, X1, mod + 2 * DM};
        pg8::gemm_phase<pg8::EpiRes<false>, pg8::StaticOrder, true, true>(F.lds, g, S, E); }
    SEAM(5);
    if (IN(6)) REP(6) { norm_mod_bf16_phase(F, X1, H, norm2_g, mod, 3, 4); }
    SEAM(6);
    if (IN(7)) REP(7) { pg8::Gemm g{H, WguT, MTOK, 2 * FF, DM}; pg8::StaticOrder S; S.init(MTOK, 2 * FF, F.G, (int)blockIdx.x); pg8::EpiSwiGLU E{ACT};
        pg8::gemm_phase<pg8::EpiSwiGLU, pg8::StaticOrder, true, true>(F.lds, g, S, E); }
    SEAM(7);
    if (IN(8)) REP(8) { pg8::Gemm g{ACT, WdT, MTOK, DM, FF}; pg8::StaticOrder S; S.init(MTOK, DM, F.G, (int)blockIdx.x); pg8::EpiRes<true> E{X1, X2, mod + 5 * DM};
        pg8::gemm_phase<pg8::EpiRes<true>, pg8::StaticOrder, true, true>(F.lds, g, S, E); }
    SEAM(8);
    if (IN(9)) REP(9) { final_norm_phase(F, X2, out, final_g); }
#undef IN
#undef SEAM
}

#ifndef MK_PER_PHASE
#define MK_PER_PHASE 0
#endif
extern "C" void kernel_launch(void* const* d_in, const int* in_sizes, int n_in, void* d_out, int out_size, void* d_ws, size_t ws_size, hipStream_t stream) {
    static int grid = 0;
    if (grid == 0) {
        if (n_in != 16 || in_sizes[0] != MTOK * DM || out_size != MTOK * DM || ws_size < WS_END) { fprintf(stderr, "kernel_launch: unexpected shapes (n_in %d, in0 %d, out %d, ws %zu)\n", n_in, n_in > 0 ? in_sizes[0] : -1, out_size, ws_size); grid = -1; return; }
        int dev = 0, cus = 0, per_cu = 0;
        if (hipGetDevice(&dev) != hipSuccess || hipDeviceGetAttribute(&cus, hipDeviceAttributeMultiprocessorCount, dev) != hipSuccess) { grid = -1; return; }
        if (hipFuncSetAttribute((const void*)fwd_kernel, hipFuncAttributeMaxDynamicSharedMemorySize, LDS_BYTES) != hipSuccess) { fprintf(stderr, "kernel_launch: hipFuncSetAttribute failed\n"); grid = -1; return; }
        if (hipOccupancyMaxActiveBlocksPerMultiprocessor(&per_cu, (const void*)fwd_kernel, 512, LDS_BYTES) != hipSuccess || per_cu < 1) { fprintf(stderr, "kernel_launch: occupancy query says %d blocks per CU\n", per_cu); }
        (void)hipGetLastError();
        grid = cus;
    }
    if (grid < 0) return;
    if (hipMemsetAsync((char*)d_ws + WS_CTL, 0, CTL_ZERO_BYTES, stream) != hipSuccess) return;
    Args a{};
    for (int i = 0; i < 16; ++i) a.in[i] = (const float*)d_in[i];
    a.out = (float*)d_out; a.ws = (unsigned char*)d_ws;
#if MK_PER_PHASE
    for (int ph = 0; ph < NPHASE; ++ph) { a.ph_lo = ph; a.ph_hi = ph + 1; hipLaunchKernelGGL(fwd_kernel, dim3(grid), dim3(512), LDS_BYTES, stream, a); }
#else
    a.ph_lo = 0; a.ph_hi = NPHASE;
    hipLaunchKernelGGL(fwd_kernel, dim3(grid), dim3(512), LDS_BYTES, stream, a);
#endif
}
```
